# Optimizing an MI355X kernel written in HIP

```python
import jax, jax.numpy as jnp
from jax import lax
import numpy as np

D_MODEL = 2048
BATCH = 2
SEQ = 16384
DEPTH = 4
DEC_BATCH = 2
DEC_SEQ = 8192
PAST_LEN = 128

GRID_W = 64
ATTN_WIDTH = D_MODEL // 2
CONV_WIDTH = D_MODEL - ATTN_WIDTH
N_HEADS = 8
HEAD_DIM = ATTN_WIDTH // N_HEADS
CONV_GROUPS = 8
CONV_GROUP_DIM = CONV_WIDTH // CONV_GROUPS
CONV_K = 3
WIN_ROWS = 8
WIN_COLS = 16
COL_BLOCK = 16
COL_BAND = 32
D_FF = -(-8 * D_MODEL // (3 * 256)) * 256
IN_WIDTH = 3 * ATTN_WIDTH + 3 * CONV_WIDTH
EPS = 1e-6
NEG_INF = -1e30

kernel_name = "hybrid_natten_shortconv_encoder"


def rms_norm(x, g):
    xf = x.astype(jnp.float32)
    y = xf * lax.rsqrt(jnp.mean(xf * xf, axis=-1, keepdims=True) + EPS)
    return (y * g.astype(jnp.float32)).astype(x.dtype)


def group_rms_norm(x, g, n_groups):
    shp = x.shape
    xg = x.reshape(shp[:-1] + (n_groups, shp[-1] // n_groups)).astype(jnp.float32)
    y = xg * lax.rsqrt(jnp.mean(xg * xg, axis=-1, keepdims=True) + EPS)
    return (y.reshape(shp) * g.astype(jnp.float32)).astype(x.dtype)


def short_conv(u, w):
    pad = (CONV_K - 1) // 2
    L = u.shape[1]
    up = jnp.pad(u, ((0, 0), (pad, CONV_K - 1 - pad), (0, 0)))
    out = up[:, 0:L] * w[0]
    for j in range(1, CONV_K):
        out = out + up[:, j:j + L] * w[j]
    return out


def neighbourhood_attention(q, k, v, rpb):
    b, L, h, dh = q.shape
    rows = L // GRID_W
    kr = min(WIN_ROWS, rows)
    n_cb = GRID_W // COL_BLOCK
    qg = q.reshape(b, rows, GRID_W, h, dh)
    kg = k.reshape(b, rows, GRID_W, h, dh)
    vg = v.reshape(b, rows, GRID_W, h, dh)

    qcol = np.arange(GRID_W)
    col_start = np.clip(qcol - WIN_COLS // 2, 0, GRID_W - WIN_COLS).reshape(n_cb, COL_BLOCK)
    band_start = np.clip(np.arange(n_cb) * COL_BLOCK - (COL_BAND - COL_BLOCK) // 2,
                         0, GRID_W - COL_BAND)
    band_cols = band_start[:, None] + np.arange(COL_BAND)
    qcols_blk = qcol.reshape(n_cb, COL_BLOCK)
    kc = band_cols[:, None, :]
    cs = col_start[:, :, None]
    col_valid = (kc >= cs) & (kc < cs + WIN_COLS)
    rel_c_idx = np.clip(kc - qcols_blk[:, :, None] + WIN_COLS - 1, 0, 2 * WIN_COLS - 2)
    col_mask = jnp.where(jnp.asarray(col_valid), 0.0, NEG_INF).astype(jnp.float32)
    rpb_c = rpb.astype(jnp.float32)[:, :, rel_c_idx] + col_mask
    scale = HEAD_DIM ** -0.5

    def row_step(r):
        r0 = jnp.clip(r - WIN_ROWS // 2, 0, rows - kr)
        q_r = lax.dynamic_index_in_dim(qg, r, axis=1, keepdims=False)
        k_r = lax.dynamic_slice_in_dim(kg, r0, kr, axis=1)
        v_r = lax.dynamic_slice_in_dim(vg, r0, kr, axis=1)
        k_band = k_r[:, :, band_cols]
        v_band = v_r[:, :, band_cols]
        q_blk = q_r.reshape(b, n_cb, COL_BLOCK, h, dh)
        s = jnp.einsum('bnqhd,brnkhd->bhnqrk', q_blk, k_band,
                       preferred_element_type=jnp.float32) * scale
        rel_r = r0 + jnp.arange(kr) - r + WIN_ROWS - 1
        bias = jnp.take(rpb_c, rel_r, axis=1)
        s = s + bias.transpose(0, 2, 3, 1, 4)[None]
        p = jax.nn.softmax(s.reshape(b, h, n_cb, COL_BLOCK, kr * COL_BAND), axis=-1)
        p = p.reshape(s.shape).astype(v.dtype)
        o = jnp.einsum('bhnqrk,brnkhd->bnqhd', p, v_band)
        return o.reshape(b, GRID_W, h, dh)

    out = lax.map(row_step, jnp.arange(rows))
    return out.transpose(1, 0, 2, 3, 4).reshape(b, L, h, dh)


def encoder_layer(x, norm1, w_in, q_gain, k_gain, rpb, conv_w, attn_out_gain,
                  conv_out_gain, w_out, norm2, w_gate, w_up, w_down):
    b, L, _ = x.shape
    hn = rms_norm(x, norm1)
    proj = hn @ w_in
    a = ATTN_WIDTH
    c = CONV_WIDTH
    q = proj[..., 0:a].reshape(b, L, N_HEADS, HEAD_DIM)
    k = proj[..., a:2 * a].reshape(b, L, N_HEADS, HEAD_DIM)
    v = proj[..., 2 * a:3 * a].reshape(b, L, N_HEADS, HEAD_DIM)
    gate_b = proj[..., 3 * a:3 * a + c]
    gate_c = proj[..., 3 * a + c:3 * a + 2 * c]
    u = proj[..., 3 * a + 2 * c:3 * a + 3 * c]
    q = rms_norm(q, q_gain)
    k = rms_norm(k, k_gain)
    attn = neighbourhood_attention(q, k, v, rpb).reshape(b, L, a)
    attn = group_rms_norm(attn, attn_out_gain, N_HEADS)
    conv = gate_b * short_conv(gate_c * u, conv_w)
    conv = group_rms_norm(conv, conv_out_gain, CONV_GROUPS)
    x = x + jnp.concatenate([attn, conv], axis=-1) @ w_out
    hn2 = rms_norm(x, norm2)
    x = x + (jax.nn.silu(hn2 @ w_gate) * (hn2 @ w_up)) @ w_down
    return x


def setup_inputs(seed: int = 0) -> dict:
    key = jax.random.key(seed)
    ks = jax.random.split(key, 16)
    f32 = jnp.float32
    nrm = lambda k, shape, s: jax.random.normal(k, shape, f32) * s
    return {
        "x_prompt": nrm(ks[0], (BATCH, SEQ, D_MODEL), 1.0),
        "x_sample": nrm(ks[1], (DEC_BATCH, DEC_SEQ, D_MODEL), 1.0),
        "norm1": 1.0 + nrm(ks[2], (DEPTH, D_MODEL), 0.05),
        "w_in": nrm(ks[3], (DEPTH, D_MODEL, IN_WIDTH), D_MODEL ** -0.5),
        "q_gain": 1.0 + nrm(ks[4], (DEPTH, HEAD_DIM), 0.05),
        "k_gain": 1.0 + nrm(ks[5], (DEPTH, HEAD_DIM), 0.05),
        "rpb": nrm(ks[6], (DEPTH, N_HEADS, 2 * WIN_ROWS - 1, 2 * WIN_COLS - 1), 0.5),
        "conv_w": nrm(ks[7], (DEPTH, CONV_K, CONV_WIDTH), CONV_K ** -0.5),
        "attn_out_gain": 1.0 + nrm(ks[8], (DEPTH, ATTN_WIDTH), 0.05),
        "conv_out_gain": 1.0 + nrm(ks[9], (DEPTH, CONV_WIDTH), 0.05),
        "w_out": nrm(ks[10], (DEPTH, D_MODEL, D_MODEL), D_MODEL ** -0.5),
        "norm2": 1.0 + nrm(ks[11], (DEPTH, D_MODEL), 0.05),
        "w_gate": nrm(ks[12], (DEPTH, D_MODEL, D_FF), D_MODEL ** -0.5),
        "w_up": nrm(ks[13], (DEPTH, D_MODEL, D_FF), D_MODEL ** -0.5),
        "w_down": nrm(ks[14], (DEPTH, D_FF, D_MODEL), D_FF ** -0.5),
    }


def reference(x_prompt, x_sample, norm1, w_in, q_gain, k_gain, rpb, conv_w,
              attn_out_gain, conv_out_gain, w_out, norm2, w_gate, w_up, w_down):
    y_prompt = x_prompt
    y_sample = x_sample
    for i in range(DEPTH):
        y_prompt = encoder_layer(y_prompt, norm1[i], w_in[i], q_gain[i], k_gain[i], rpb[i],
                                 conv_w[i], attn_out_gain[i], conv_out_gain[i], w_out[i],
                                 norm2[i], w_gate[i], w_up[i], w_down[i])
        y_sample = encoder_layer(y_sample, norm1[i], w_in[i], q_gain[i], k_gain[i], rpb[i],
                                 conv_w[i], attn_out_gain[i], conv_out_gain[i], w_out[i],
                                 norm2[i], w_gate[i], w_up[i], w_down[i])
    return (y_prompt, y_sample)
```

```cpp
#include <hip/hip_runtime.h>
#include <cstdio>
#include <cstdint>

__device__ __forceinline__ int tid_of(int wv) { asm volatile("" : "+s"(wv)); unsigned z = 0u; asm volatile("" : "+v"(z));
    return (wv << 6) | (int)__builtin_amdgcn_mbcnt_hi(~0u, __builtin_amdgcn_mbcnt_lo(~0u, z)); }
namespace pg8 {
#define PG8_LAS __attribute__((address_space(3)))
typedef unsigned short bf16_t;
typedef short bf16x8 __attribute__((ext_vector_type(8)));
typedef float f32x4 __attribute__((ext_vector_type(4)));
typedef unsigned u32x4 __attribute__((ext_vector_type(4)));
constexpr int BM = 256, BK = 64, HALF = 128, HTB = HALF * BK * 2  , STAGE_BYTES = 8 * HTB, NXCD = 8, WGM = 4;

__host__ __device__ __forceinline__ int lds_byte(int r, int c) { const int st = (r >> 4) * 2 + (c >> 5), rr = r & 15, cc = c & 31, ob = rr * 64 + cc * 2; return st * 1024 + (ob ^ (((ob >> 9) & 1) << 5)); }
__host__ __device__ __forceinline__ void stage_rc(int b, int& R, int& C) { const int st = b / 1024, sb = b % 1024, swz = sb ^ (((sb >> 9) & 1) << 5); R = (st >> 1) * 16 + swz / 64; C = (st & 1) * 32 + (swz % 64) / 2; }
__host__ __device__ __forceinline__ int perm32(int rho) { const int n = rho >> 4, i = rho & 15; return 8 * (i >> 2) + 4 * n + (i & 3); }

struct Unit { int pm, pn; };
struct Gemm { const bf16_t* A; const bf16_t* Bt; int M, N, K; };

struct StaticOrder {
    int nM, nN, nwg, G, c;
    __host__ __device__ void init(int M, int N, int G_, int c_) { nM = M / BM; nN = N / BM; nwg = nM * nN; G = G_; c = c_; }
    __host__ __device__ bool next(int i, Unit& u) const {
        const long L = (long)i * G + c; if (L >= nwg) return false;
        int wgid = (int)L; { const int q = nwg / NXCD, r = nwg % NXCD, xcd = wgid % NXCD, off = wgid / NXCD; wgid = (xcd < r ? xcd * (q + 1) : r * (q + 1) + (xcd - r) * q) + off; }
        const int nig = WGM * nN, gid = wgid / nig, fm = gid * WGM, gsz = (nM - fm) < WGM ? (nM - fm) : WGM;
        u.pm = fm + ((wgid % nig) % gsz); u.pn = (wgid % nig) / gsz; return true;
    }
    __device__ __forceinline__ void a_ready(const Unit&) const {}
    __device__ __forceinline__ void done(const Unit&) const {}
    __device__ __forceinline__ void tail(int, int, int) const {}
};

struct StealOrder {
    StaticOrder so; int S0, ntail; unsigned* ctr; PG8_LAS volatile int* slot;
    __device__ void init(int M, int N, int G_, int c_, int S0_, unsigned* ctr_, PG8_LAS volatile int* slot_) { so.init(M, N, G_, c_); S0 = S0_; ctr = ctr_; slot = slot_; ntail = so.nwg - S0_ * G_; }
    __device__ __forceinline__ bool unit_of(int wgid, Unit& u) const {
        const int nig = WGM * so.nN, gid = wgid / nig, fm = gid * WGM, gsz = (so.nM - fm) < WGM ? (so.nM - fm) : WGM;
        u.pm = fm + ((wgid % nig) % gsz); u.pn = (wgid % nig) / gsz; return true; }
    __device__ __forceinline__ bool next(int i, Unit& u) const {
        if (i < S0) return so.next(i, u);
        const int w = __builtin_amdgcn_readfirstlane(slot[i & 1]); if (w < 0) return false;
        return unit_of(w, u);
    }
    __device__ __forceinline__ void a_ready(const Unit&) const {}
    __device__ __forceinline__ void done(const Unit&) const {}
    __device__ __forceinline__ void tail(int i, int wid, int lane) const {
        if (i + 2 < S0 || wid != 0) return;
        if (lane == 0) {
            const unsigned t = __hip_atomic_fetch_add(ctr, 1u, __ATOMIC_RELAXED, __HIP_MEMORY_SCOPE_AGENT);
            int w = -1;
            if ((int)t < ntail) { const int q = so.nwg / NXCD, per = ntail / NXCD, xcd = (int)t % NXCD, v = (int)t / NXCD; w = xcd * q + (q - per) + v; }
            slot[i & 1] = w;
        }
        asm volatile("s_waitcnt lgkmcnt(0)" ::: "memory");
    }
};

__device__ __forceinline__ unsigned cvt_pk_bf16(float lo, float hi) { unsigned r; asm volatile("v_cvt_pk_bf16_f32 %0, %1, %2" : "=v"(r) : "v"(lo), "v"(hi)); return r; }

constexpr float RMS_EPS = 1e-6f;
__device__ __forceinline__ float rsvq(float x) { return rsqrtf(x); }

__device__ __forceinline__ void load_rows8(const float* p, int row0, float (&v)[2][4]) {
#pragma unroll
    for (int ai = 0; ai < 2; ++ai)
#pragma unroll
        for (int m = 0; m < 4; ++m) v[ai][m] = p[row0 + ai * HALF + m * 16];
    asm volatile("" : "+v"(v[0][0]), "+v"(v[0][1]), "+v"(v[0][2]), "+v"(v[0][3]), "+v"(v[1][0]), "+v"(v[1][1]), "+v"(v[1][2]), "+v"(v[1][3]));
}

typedef int i32x4 __attribute__((ext_vector_type(4)));
__device__ __forceinline__ f32x4 tof4(const f32x4& a) { return a; }
__device__ __forceinline__ f32x4 tof4(const i32x4& a) { return (f32x4){(float)a[0], (float)a[1], (float)a[2], (float)a[3]}; }
struct EpiInProj {
    static constexpr bool PERM = true, AFTER_DRAIN = false;
    bf16_t* P; const float* rs1; const float* qg; const float* kg; PG8_LAS float* tab; const float* sbc;
    template <class AccT>
    __device__ __forceinline__ void operator()(const AccT (&acc)[2][2][4][2], const Unit& u, int wr, int wc, int fr, int fq) const {
        const int row0 = u.pm * BM + wr * 64 + fr, col0 = u.pn * BM + wc * 32 + 8 * fq;
        const bool isq = u.pn < 4, isqk = u.pn < 8;
        f32x4 cs[2][2];
#pragma unroll
        for (int bj = 0; bj < 2; ++bj)
#pragma unroll
            for (int n = 0; n < 2; ++n) cs[bj][n] = sbc ? *(const f32x4*)(sbc + col0 + bj * HALF + 4 * n) : (f32x4){1.f, 1.f, 1.f, 1.f};
        if (isqk) {
            float cf[8];
            { const int d0 = wc * 32 + 8 * fq; const float* gp = isq ? qg : kg; const float sc = isq ? 0.08838834764831845f * 1.4426950408889634f : 1.0f;
#pragma unroll
              for (int j = 0; j < 8; ++j) cf[j] = gp[d0 + j] * sc; }
            float rsv[2][4]; load_rows8(rs1, row0, rsv);
#pragma unroll
            for (int ai = 0; ai < 2; ++ai)
#pragma unroll
                for (int m = 0; m < 4; ++m) {
                    const int rl = ai * HALF + wr * 64 + m * 16 + fr;
                    const float rs = rsv[ai][m];
#pragma unroll
                    for (int bj = 0; bj < 2; ++bj) {
                        const f32x4 v0 = tof4(acc[ai][bj][m][0]) * (cs[bj][0] * rs), v1 = tof4(acc[ai][bj][m][1]) * (cs[bj][1] * rs);
                        float s = (v0[0] * v0[0] + v0[1] * v0[1]) + (v0[2] * v0[2] + v0[3] * v0[3]) + (v1[0] * v1[0] + v1[1] * v1[1]) + (v1[2] * v1[2] + v1[3] * v1[3]);
                        s += __shfl_xor(s, 16); s += __shfl_xor(s, 32);
                        if (fq == 0) tab[rl * 8 + bj * 4 + wc] = s;
                    }
                }
            asm volatile("s_waitcnt lgkmcnt(0)" ::: "memory"); __builtin_amdgcn_s_barrier(); asm volatile("" ::: "memory");
#pragma unroll
            for (int ai = 0; ai < 2; ++ai)
#pragma unroll
                for (int m = 0; m < 4; ++m) {
                    const int rl = ai * HALF + wr * 64 + m * 16 + fr;
                    bf16_t* rowp = P + (size_t)(u.pm * BM + rl) * 5120 + col0;
#pragma unroll
                    for (int bj = 0; bj < 2; ++bj) {
                        const f32x4 t = *(const PG8_LAS f32x4*)(tab + rl * 8 + bj * 4);
                        const float rn = rsvq(((t[0] + t[1]) + (t[2] + t[3])) * (1.0f / 128.0f) + RMS_EPS) * rsv[ai][m];
                        const f32x4 v0 = tof4(acc[ai][bj][m][0]) * (cs[bj][0] * rn), v1 = tof4(acc[ai][bj][m][1]) * (cs[bj][1] * rn);
                        u32x4 w; w.x = cvt_pk_bf16(v0[0] * cf[0], v0[1] * cf[1]); w.y = cvt_pk_bf16(v0[2] * cf[2], v0[3] * cf[3]);
                        w.z = cvt_pk_bf16(v1[0] * cf[4], v1[1] * cf[5]); w.w = cvt_pk_bf16(v1[2] * cf[6], v1[3] * cf[7]);
                        *(u32x4*)(rowp + bj * HALF) = w;
                    }
                }
        } else if (u.pn >= 16) {
            float rsv[2][4]; load_rows8(rs1, row0, rsv);
            const f32x4 cp0 = cs[0][0] * cs[1][0], cp1 = cs[0][1] * cs[1][1];
            bf16_t* cup = P + 4096 + (u.pn - 16) * HALF + wc * 32 + 8 * fq;
#pragma unroll
            for (int ai = 0; ai < 2; ++ai)
#pragma unroll
                for (int m = 0; m < 4; ++m) {
                    const int r = row0 + ai * HALF + m * 16;
                    const float rs2 = rsv[ai][m] * rsv[ai][m];
                    const f32x4 v0 = tof4(acc[ai][0][m][0]) * tof4(acc[ai][1][m][0]) * (cp0 * rs2), v1 = tof4(acc[ai][0][m][1]) * tof4(acc[ai][1][m][1]) * (cp1 * rs2);
                    u32x4 w; w.x = cvt_pk_bf16(v0[0], v0[1]); w.y = cvt_pk_bf16(v0[2], v0[3]); w.z = cvt_pk_bf16(v1[0], v1[1]); w.w = cvt_pk_bf16(v1[2], v1[3]);
                    *(u32x4*)(cup + (size_t)r * 5120) = w;
                }
        } else {
            float rsv[2][4]; load_rows8(rs1, row0, rsv);
#pragma unroll
            for (int ai = 0; ai < 2; ++ai)
#pragma unroll
                for (int m = 0; m < 4; ++m) {
                    const int r = row0 + ai * HALF + m * 16;
                    const float rs = rsv[ai][m];
                    bf16_t* rowp = P + (size_t)r * 5120 + col0;
#pragma unroll
                    for (int bj = 0; bj < 2; ++bj) {
                        const f32x4 v0 = tof4(acc[ai][bj][m][0]) * (cs[bj][0] * rs), v1 = tof4(acc[ai][bj][m][1]) * (cs[bj][1] * rs);
                        u32x4 w; w.x = cvt_pk_bf16(v0[0], v0[1]); w.y = cvt_pk_bf16(v0[2], v0[3]); w.z = cvt_pk_bf16(v1[0], v1[1]); w.w = cvt_pk_bf16(v1[2], v1[3]);
                        *(u32x4*)(rowp + bj * HALF) = w;
                    }
                }
        }
    }
};

struct EpiResid {
    static constexpr bool PERM = true, AFTER_DRAIN = false;
    float* X; bf16_t* XB; float* ssn;
    __device__ __forceinline__ void operator()(const f32x4 (&acc)[2][2][4][2], const Unit& u, int wr, int wc, int fr, int fq) const {
        const int row0 = u.pm * BM + wr * 64 + fr, col0 = u.pn * BM + wc * 32 + 8 * fq;
#pragma unroll
        for (int ai = 0; ai < 2; ++ai) {
            u32x4 o[4][2];
#pragma unroll
            for (int m = 0; m < 4; ++m) { const bf16_t* xp = XB + (size_t)(row0 + ai * HALF + m * 16) * 2048 + col0;
#pragma unroll
                for (int bj = 0; bj < 2; ++bj) o[m][bj] = *(const u32x4*)(xp + bj * HALF); }
#pragma unroll
            for (int m = 0; m < 4; ++m) {
                const int r = row0 + ai * HALF + m * 16;
                float s = 0.f;
#pragma unroll
                for (int bj = 0; bj < 2; ++bj) {
                    const u32x4 w0 = o[m][bj];
                    f32x4 o0 = {__builtin_bit_cast(float, w0.x << 16), __builtin_bit_cast(float, w0.x & 0xffff0000u), __builtin_bit_cast(float, w0.y << 16), __builtin_bit_cast(float, w0.y & 0xffff0000u)};
                    f32x4 o1 = {__builtin_bit_cast(float, w0.z << 16), __builtin_bit_cast(float, w0.z & 0xffff0000u), __builtin_bit_cast(float, w0.w << 16), __builtin_bit_cast(float, w0.w & 0xffff0000u)};
                    o0 = o0 + acc[ai][bj][m][0]; o1 = o1 + acc[ai][bj][m][1];
                    if (X) { float* xp = X + (size_t)r * 2048 + col0 + bj * HALF; *(f32x4*)xp = o0; *(f32x4*)(xp + 4) = o1; }
                    else {
                        if (ssn) s += (o0[0] * o0[0] + o0[1] * o0[1]) + (o0[2] * o0[2] + o0[3] * o0[3]) + (o1[0] * o1[0] + o1[1] * o1[1]) + (o1[2] * o1[2] + o1[3] * o1[3]);
                        u32x4 w; w.x = cvt_pk_bf16(o0[0], o0[1]); w.y = cvt_pk_bf16(o0[2], o0[3]); w.z = cvt_pk_bf16(o1[0], o1[1]); w.w = cvt_pk_bf16(o1[2], o1[3]);
                        *(u32x4*)(XB + (size_t)r * 2048 + col0 + bj * HALF) = w; }
                }
                if (!X && ssn) { s += __shfl_xor(s, 16); s += __shfl_xor(s, 32); if (fq == 0) ssn[(size_t)(u.pn * 4 + wc) * 49152 + r] = s; }
            }
        }
    }
};

typedef int i32x4 __attribute__((ext_vector_type(4)));
struct EpiResidI8 {
    static constexpr bool PERM = true, AFTER_DRAIN = false;
    float* X; bf16_t* XB; float* ssn; const float* hs; const float* sbd; float hconst;
    __device__ __forceinline__ void operator()(const i32x4 (&acc)[2][2][4][2], const Unit& u, int wr, int wc, int fr, int fq) const {
        const int row0 = u.pm * BM + wr * 64 + fr, col0 = u.pn * BM + wc * 32 + 8 * fq;
        f32x4 cs[2][2];
#pragma unroll
        for (int bj = 0; bj < 2; ++bj) { cs[bj][0] = *(const f32x4*)(sbd + col0 + bj * HALF); cs[bj][1] = *(const f32x4*)(sbd + col0 + bj * HALF + 4); }
        float rsv[2][4];
        if (hs) load_rows8(hs, row0, rsv); else {
#pragma unroll
            for (int i = 0; i < 8; ++i) rsv[i >> 2][i & 3] = hconst; }
#pragma unroll
        for (int ai = 0; ai < 2; ++ai) {
            u32x4 o[4][2];
#pragma unroll
            for (int m = 0; m < 4; ++m) { const bf16_t* xp = XB + (size_t)(row0 + ai * HALF + m * 16) * 2048 + col0;
#pragma unroll
                for (int bj = 0; bj < 2; ++bj) o[m][bj] = *(const u32x4*)(xp + bj * HALF); }
#pragma unroll
            for (int m = 0; m < 4; ++m) {
                const int r = row0 + ai * HALF + m * 16;
                const float rs = rsv[ai][m];
                float s = 0.f;
#pragma unroll
                for (int bj = 0; bj < 2; ++bj) {
                    const u32x4 w0 = o[m][bj];
                    f32x4 o0 = {__builtin_bit_cast(float, w0.x << 16), __builtin_bit_cast(float, w0.x & 0xffff0000u), __builtin_bit_cast(float, w0.y << 16), __builtin_bit_cast(float, w0.y & 0xffff0000u)};
                    f32x4 o1 = {__builtin_bit_cast(float, w0.z << 16), __builtin_bit_cast(float, w0.z & 0xffff0000u), __builtin_bit_cast(float, w0.w << 16), __builtin_bit_cast(float, w0.w & 0xffff0000u)};
                    const i32x4 a0 = acc[ai][bj][m][0], a1 = acc[ai][bj][m][1];
                    o0 = o0 + (f32x4){(float)a0[0], (float)a0[1], (float)a0[2], (float)a0[3]} * (cs[bj][0] * rs);
                    o1 = o1 + (f32x4){(float)a1[0], (float)a1[1], (float)a1[2], (float)a1[3]} * (cs[bj][1] * rs);
                    if (X) { float* xp = X + (size_t)r * 2048 + col0 + bj * HALF; *(f32x4*)xp = o0; *(f32x4*)(xp + 4) = o1; }
                    else {
                        if (ssn) s += (o0[0] * o0[0] + o0[1] * o0[1]) + (o0[2] * o0[2] + o0[3] * o0[3]) + (o1[0] * o1[0] + o1[1] * o1[1]) + (o1[2] * o1[2] + o1[3] * o1[3]);
                        u32x4 w; w.x = cvt_pk_bf16(o0[0], o0[1]); w.y = cvt_pk_bf16(o0[2], o0[3]); w.z = cvt_pk_bf16(o1[0], o1[1]); w.w = cvt_pk_bf16(o1[2], o1[3]);
                        *(u32x4*)(XB + (size_t)r * 2048 + col0 + bj * HALF) = w; }
                }
                if (!X && ssn) { s += __shfl_xor(s, 16); s += __shfl_xor(s, 32); if (fq == 0) ssn[(size_t)(u.pn * 4 + wc) * 49152 + r] = s; }
            }
        }
    }
};

struct EpiGateUp {
    static constexpr bool PERM = true, AFTER_DRAIN = false;
    bf16_t* H; const float* ss;
    __device__ __forceinline__ void operator()(const f32x4 (&acc)[2][2][4][2], const Unit& u, int wr, int wc, int fr, int fq) const {
        const int row0 = u.pm * BM + wr * 64 + fr, col0 = u.pn * HALF + wc * 32 + 8 * fq;
        float rsv[2][4]; load_rows8(ss, row0, rsv);
#pragma unroll
        for (int ai = 0; ai < 2; ++ai)
#pragma unroll
            for (int m = 0; m < 4; ++m) {
                const int r = row0 + ai * HALF + m * 16;
                const float rs = rsv[ai][m];
                float hv[8];
#pragma unroll
                for (int n = 0; n < 2; ++n)
#pragma unroll
                    for (int j = 0; j < 4; ++j) {
                        const float g = acc[ai][0][m][n][j] * rs, up = acc[ai][1][m][n][j] * rs;
                        const float sg = g * __builtin_amdgcn_rcpf(1.0f + __builtin_amdgcn_exp2f(-1.4426950408889634f * g));
                        hv[n * 4 + j] = sg * up;
                    }
                u32x4 w; w.x = cvt_pk_bf16(hv[0], hv[1]); w.y = cvt_pk_bf16(hv[2], hv[3]); w.z = cvt_pk_bf16(hv[4], hv[5]); w.w = cvt_pk_bf16(hv[6], hv[7]);
                *(u32x4*)(H + (size_t)r * 5632 + col0) = w;
            }
    }
};

typedef int i32x4 __attribute__((ext_vector_type(4)));
__device__ __forceinline__ f32x4 mma_bf(bf16x8 a, bf16x8 b, f32x4 c) { return __builtin_amdgcn_mfma_f32_16x16x32_bf16(a, b, c, 0, 0, 0); }
__device__ __forceinline__ i32x4 mma_i8(bf16x8 a, bf16x8 b, i32x4 c) { return __builtin_amdgcn_mfma_i32_16x16x64_i8(__builtin_bit_cast(i32x4, a), __builtin_bit_cast(i32x4, b), c, 0, 0, 0); }
struct EpiGateUpI8 {
    static constexpr bool PERM = true, AFTER_DRAIN = false;
    bf16_t* H; const float* rowf; const float* sb;
    __device__ __forceinline__ void operator()(const i32x4 (&acc)[2][2][4][2], const Unit& u, int wr, int wc, int fr, int fq) const {
        const int row0 = u.pm * BM + wr * 64 + fr, col0 = u.pn * HALF + wc * 32 + 8 * fq;
        float sg[8], su[8];
        { const float* sp = sb + u.pn * BM + wc * 32 + 8 * fq; const f32x4 a = *(const f32x4*)sp, b = *(const f32x4*)(sp + 4), c = *(const f32x4*)(sp + HALF), d = *(const f32x4*)(sp + HALF + 4);
          sg[0] = a[0]; sg[1] = a[1]; sg[2] = a[2]; sg[3] = a[3]; sg[4] = b[0]; sg[5] = b[1]; sg[6] = b[2]; sg[7] = b[3];
          su[0] = c[0]; su[1] = c[1]; su[2] = c[2]; su[3] = c[3]; su[4] = d[0]; su[5] = d[1]; su[6] = d[2]; su[7] = d[3]; }
#pragma unroll
        for (int e = 0; e < 8; ++e) { sg[e] *= 1.4426950408889634f; su[e] *= 0.6931471805599453f; }
        float rsv[2][4]; load_rows8(rowf, row0, rsv);
#pragma unroll
        for (int ai = 0; ai < 2; ++ai)
#pragma unroll
            for (int m = 0; m < 4; ++m) {
                const int r = row0 + ai * HALF + m * 16;
                const float rs = rsv[ai][m];
                float g2[8], gu[8], hv[8];
#pragma unroll
                for (int e = 0; e < 8; ++e) { g2[e] = (float)acc[ai][0][m][e >> 2][e & 3] * (rs * sg[e]); gu[e] = g2[e] * ((float)acc[ai][1][m][e >> 2][e & 3] * (rs * su[e])); }
#pragma unroll
                for (int e = 0; e < 8; ++e) g2[e] = __builtin_amdgcn_exp2f(-g2[e]);
#pragma unroll
                for (int e = 0; e < 8; ++e) g2[e] = __builtin_amdgcn_rcpf(1.0f + g2[e]);
#pragma unroll
                for (int e = 0; e < 8; ++e) hv[e] = gu[e] * g2[e];
                u32x4 w; w.x = cvt_pk_bf16(hv[0], hv[1]); w.y = cvt_pk_bf16(hv[2], hv[3]); w.z = cvt_pk_bf16(hv[4], hv[5]); w.w = cvt_pk_bf16(hv[6], hv[7]);
                *(u32x4*)(H + (size_t)r * 5632 + col0) = w;
            }
    }
};

template <bool I8> struct AccSel { typedef f32x4 type; };
template <> struct AccSel<true> { typedef i32x4 type; };
template <class Epi, class Sched, bool ALIGN_EPI = false, bool SP2 = false, bool I8 = false>
__device__ __forceinline__ void gemm_phase(PG8_LAS unsigned char* lds, const Gemm g, const Sched& S, const Epi& E, const int wv) {
    int tid_ = tid_of(wv); asm volatile("" : "+v"(tid_));
    const int tid = tid_, wid = __builtin_amdgcn_readfirstlane(tid >> 6), lane = tid & 63, wr = wid >> 2, wc = wid & 3, fr = lane & 15, fq = lane >> 4;
    const int K = g.K, nt = K / BK;
    unsigned voffA[2], voffB[2];
#pragma unroll
    for (int i = 0; i < 2; ++i) { int R, C; stage_rc(tid * 16 + i * 8192, R, C); const int Rb = Epi::PERM ? ((R & ~31) + perm32(R & 31)) : R;
        voffA[i] = (unsigned)(R * K + C) * 2u; voffB[i] = (unsigned)(Rb * K + C) * 2u; }
    const size_t kstep = (size_t)(BK * 2);
    const size_t hstep = (size_t)HALF * K * 2;
    const size_t tstep = 2 * hstep;
    const unsigned ldsw = (unsigned)wid * 1024u;
    const int aoff = lds_byte(wr * 64 + fr, fq * 8), boff = lds_byte(wc * 32 + fr, fq * 8);
#define PG8_SA(b, h) (((b) * 2 + (h)) * HTB)
#define PG8_SB(b, h) ((4 + (b) * 2 + (h)) * HTB)
#define PG8_STAGE(bufoff, gbase, voff) do { _Pragma("unroll") for (int _i = 0; _i < 2; ++_i) \
        __builtin_amdgcn_global_load_lds((const unsigned*)((const char*)(gbase) + (voff)[_i]), (PG8_LAS unsigned*)(lds + (bufoff) + ldsw + _i * 8192), 16, 0, 0); } while (0)
#define PG8_LDA(dst, b, h) do { _Pragma("unroll") for (int m = 0; m < 4; ++m) _Pragma("unroll") for (int k = 0; k < 2; ++k) dst[m][k] = *(const PG8_LAS bf16x8*)(lds + PG8_SA(b, h) + aoff + m * 2048 + k * 1024); } while (0)
#define PG8_LDB(dst, b, h) do { _Pragma("unroll") for (int n = 0; n < 2; ++n) _Pragma("unroll") for (int k = 0; k < 2; ++k) dst[n][k] = *(const PG8_LAS bf16x8*)(lds + PG8_SB(b, h) + boff + n * 2048 + k * 1024); } while (0)
#define PG8_MMA(ai, bj, At, Bt) do { __builtin_amdgcn_s_setprio(1); _Pragma("unroll") for (int m = 0; m < 4; ++m) _Pragma("unroll") for (int n = 0; n < 2; ++n) _Pragma("unroll") for (int k = 0; k < 2; ++k) \
        { if constexpr (I8) acc[ai][bj][m][n] = mma_i8(Bt[n][k], At[m][k], acc[ai][bj][m][n]); else acc[ai][bj][m][n] = mma_bf(Bt[n][k], At[m][k], acc[ai][bj][m][n]); } __builtin_amdgcn_s_setprio(0); } while (0)
#define PG8_WAIT_V(n) asm volatile("s_waitcnt vmcnt(" #n ")" ::: "memory")
#define PG8_WAIT_L(n) asm volatile("s_waitcnt lgkmcnt(" #n ")" ::: "memory")
#define PG8_BAR __builtin_amdgcn_s_barrier()
#define PG8_SCHED __builtin_amdgcn_sched_barrier(0)
    Unit cur, nxt; int ui = 0;
    if (!S.next(0, cur)) return;
    typedef typename AccSel<I8>::type acc_t;
    acc_t acc[2][2][4][2];
#pragma unroll
    for (int a = 0; a < 2; ++a)
#pragma unroll
        for (int b = 0; b < 2; ++b)
#pragma unroll
            for (int m = 0; m < 4; ++m)
#pragma unroll
                for (int n = 0; n < 2; ++n) acc[a][b][m][n] = (acc_t){0, 0, 0, 0};
    bf16x8 At[4][2], B0[2][2], B1[2][2];
    const char* cA = (const char*)g.A + (size_t)cur.pm * tstep; const char* cB = (const char*)g.Bt + (size_t)cur.pn * tstep;
    S.a_ready(cur);
    if constexpr (SP2) {
        PG8_STAGE(PG8_SB(0, 0), cB, voffB); PG8_STAGE(PG8_SB(0, 1), cB + hstep, voffB); PG8_STAGE(PG8_SA(0, 0), cA, voffA); PG8_STAGE(PG8_SA(0, 1), cA + hstep, voffA);
        if (wr == 1) PG8_BAR;
        PG8_WAIT_V(2); PG8_BAR;
        PG8_STAGE(PG8_SB(1, 0), cB + kstep, voffB); PG8_STAGE(PG8_SA(1, 0), cA + kstep, voffA); PG8_STAGE(PG8_SB(1, 1), cB + hstep + kstep, voffB);
        PG8_WAIT_V(6); PG8_BAR;
    } else {
        PG8_STAGE(PG8_SB(0, 0), cB, voffB); PG8_STAGE(PG8_SA(0, 0), cA, voffA); PG8_STAGE(PG8_SB(0, 1), cB + hstep, voffB); PG8_STAGE(PG8_SA(0, 1), cA + hstep, voffA);
        if (wr == 1) PG8_BAR;
        PG8_WAIT_V(4); PG8_BAR;
        PG8_STAGE(PG8_SB(1, 0), cB + kstep, voffB); PG8_STAGE(PG8_SA(1, 0), cA + kstep, voffA); PG8_STAGE(PG8_SB(1, 1), cB + hstep + kstep, voffB);
        PG8_WAIT_V(6); PG8_BAR;
    }
    for (;;) {
        const bool has_next = S.next(ui + 1, nxt);
        const char* nA = has_next ? (const char*)g.A + (size_t)nxt.pm * tstep : cA; const char* nB = has_next ? (const char*)g.Bt + (size_t)nxt.pn * tstep : cB;
        for (int t = 0; t < nt; t += 2) {
            const bool last = (t == nt - 2);
            const char* a1 = cA + (size_t)(t + 1) * kstep;
            const char* a2 = last ? nA : cA + (size_t)(t + 2) * kstep; const char* b2 = last ? nB : cB + (size_t)(t + 2) * kstep;
            const char* a3 = a2 + kstep; const char* b3 = b2 + kstep;
            if (last && has_next) S.a_ready(nxt);
            if constexpr (SP2) {
            PG8_LDB(B0, 0, 0); PG8_LDB(B1, 0, 1); PG8_SCHED; PG8_LDA(At, 0, 0); PG8_STAGE(PG8_SA(1, 1), a1 + hstep, voffA);
            PG8_WAIT_V(8); PG8_WAIT_L(0); PG8_BAR; PG8_MMA(0, 0, At, B0); PG8_MMA(0, 1, At, B1); PG8_BAR; PG8_SCHED;
            PG8_LDA(At, 0, 1); PG8_STAGE(PG8_SB(0, 0), b2, voffB); PG8_STAGE(PG8_SB(0, 1), b2 + hstep, voffB); PG8_STAGE(PG8_SA(0, 0), a2, voffA);
            PG8_WAIT_V(8); PG8_WAIT_L(0); PG8_BAR; PG8_MMA(1, 0, At, B0); PG8_MMA(1, 1, At, B1); PG8_BAR; PG8_SCHED;
            PG8_LDB(B0, 1, 0); PG8_LDB(B1, 1, 1); PG8_SCHED; PG8_LDA(At, 1, 0); PG8_STAGE(PG8_SA(0, 1), a2 + hstep, voffA);
            PG8_WAIT_V(8); PG8_WAIT_L(0); PG8_BAR; PG8_MMA(0, 0, At, B0); PG8_MMA(0, 1, At, B1); PG8_BAR; PG8_SCHED;
            PG8_LDA(At, 1, 1); PG8_STAGE(PG8_SB(1, 0), b3, voffB); PG8_STAGE(PG8_SB(1, 1), b3 + hstep, voffB); PG8_STAGE(PG8_SA(1, 0), a3, voffA);
            PG8_WAIT_V(8); PG8_WAIT_L(0); PG8_BAR; PG8_MMA(1, 0, At, B0); PG8_MMA(1, 1, At, B1); PG8_BAR; PG8_SCHED;
            } else {
            PG8_LDB(B0, 0, 0); PG8_SCHED; PG8_LDA(At, 0, 0); PG8_STAGE(PG8_SA(1, 1), a1 + hstep, voffA);
            PG8_WAIT_L(8); PG8_BAR; PG8_WAIT_L(0); PG8_MMA(0, 0, At, B0); PG8_BAR; PG8_SCHED;
            PG8_LDB(B1, 0, 1); PG8_STAGE(PG8_SB(0, 0), b2, voffB);
            PG8_BAR; PG8_WAIT_L(0); PG8_MMA(0, 1, At, B1); PG8_BAR;
            PG8_LDA(At, 0, 1); PG8_STAGE(PG8_SA(0, 0), a2, voffA);
            PG8_BAR; PG8_WAIT_L(0); PG8_MMA(1, 0, At, B0); PG8_BAR; PG8_SCHED;
            PG8_STAGE(PG8_SB(0, 1), b2 + hstep, voffB);
            PG8_WAIT_V(6); PG8_BAR; PG8_MMA(1, 1, At, B1); PG8_BAR;
            PG8_LDB(B0, 1, 0); PG8_SCHED; PG8_LDA(At, 1, 0); PG8_STAGE(PG8_SA(0, 1), a2 + hstep, voffA);
            PG8_WAIT_L(8); PG8_BAR; PG8_WAIT_L(0); PG8_MMA(0, 0, At, B0); PG8_BAR; PG8_SCHED;
            PG8_LDB(B1, 1, 1); PG8_STAGE(PG8_SB(1, 0), b3, voffB);
            PG8_BAR; PG8_WAIT_L(0); PG8_MMA(0, 1, At, B1); PG8_BAR;
            PG8_LDA(At, 1, 1); PG8_STAGE(PG8_SA(1, 0), a3, voffA);
            PG8_BAR; PG8_WAIT_L(0); PG8_MMA(1, 0, At, B0); PG8_BAR; PG8_SCHED;
            PG8_STAGE(PG8_SB(1, 1), b3 + hstep, voffB);
            PG8_WAIT_V(6); PG8_BAR; PG8_MMA(1, 1, At, B1); PG8_BAR;
            }
        }
        S.tail(ui, wid, lane);
        if constexpr (ALIGN_EPI) { if (wr == 0) PG8_BAR; }
        if constexpr (!Epi::AFTER_DRAIN) { E(acc, cur, wr, wc, fr, fq); S.done(cur); }
        if (!has_next) break;
#pragma unroll
        for (int a = 0; a < 2; ++a)
#pragma unroll
            for (int b = 0; b < 2; ++b)
#pragma unroll
                for (int m = 0; m < 4; ++m)
#pragma unroll
                    for (int n = 0; n < 2; ++n) acc[a][b][m][n] = (acc_t){0, 0, 0, 0};
        cur = nxt; cA = nA; cB = nB; ++ui;
        if constexpr (ALIGN_EPI) { if (wr == 1) PG8_BAR; }
    }
    PG8_WAIT_V(0);
    if constexpr (!ALIGN_EPI) { if (wr == 0) PG8_BAR; }
    PG8_BAR;
#undef PG8_SA
#undef PG8_SB
#undef PG8_STAGE
#undef PG8_LDA
#undef PG8_LDB
#undef PG8_MMA
#undef PG8_WAIT_V
#undef PG8_WAIT_L
#undef PG8_BAR
#undef PG8_SCHED
}
}

#ifndef PG8_SP2
#define PG8_SP2 true
#endif
#ifndef PG8_ALIGN
#define PG8_ALIGN true
#endif

constexpr int NWAVES = 8;
constexpr int PW = 5120;
__device__ __forceinline__ int in_dst_col(int n) { if (n < 4096) return n; const int isu = n >= 5120 ? 1 : 0, c = n - 4096 - isu * 1024; return 4096 + (c >> 7) * 256 + isu * 128 + (c & 127); }
constexpr int D = 2048, NIN = 6144, FF = 5632, NGU = 2 * FF, DEPTH = 4, HD = 128, NH = 8, AW = 1024;
constexpr int M_P = 2 * 16384, M_S = 2 * 8192, M = M_P + M_S;
constexpr int GRID_W = 64;
constexpr float YC = 22.627416997969522f, YQ = 127.0f / YC, YS = YC / 127.0f;
#ifndef DUP_MASK
#define DUP_MASK 0
#endif
#define DUPN(bit) ((DUP_MASK & (bit)) ? 2 : 1)
#ifndef P3I8_FROM
#define P3I8_FROM 1
#endif
#ifndef P1I8_FROM
#define P1I8_FROM 1
#endif
#ifndef MK_N_LAUNCHES
#define MK_N_LAUNCHES 1
#endif

constexpr size_t MiB = 1u << 20;
constexpr size_t WS_CTL = 0, CTL_BYTES = 1 * MiB;
constexpr size_t ZERO_BYTES = 1 * MiB;
constexpr size_t WS_CMAX = 256 * 1024;
constexpr size_t WS_CMAXD = 448 * 1024;
constexpr size_t WS_H8 = 864 * MiB;
constexpr size_t WS_CMAXO = 480 * 1024;
constexpr size_t WS_CMAXI = 512 * 1024;
constexpr size_t WS_RS = 1 * MiB;
constexpr size_t WS_SSP = 2 * MiB;
constexpr size_t WS_SB = 8 * MiB;
constexpr size_t WS_WIN = 20 * MiB, WS_WOUT = 44 * MiB, WS_WGU = 52 * MiB, WS_WD = 74 * MiB;
constexpr size_t WS_XB = 96 * MiB;
constexpr size_t WS_P = 288 * MiB;
constexpr size_t WS_Y = 864 * MiB;
constexpr size_t WS_XQ = 1056 * MiB;
constexpr size_t WS_H = 288 * MiB;
constexpr size_t WS_END = 1152 * MiB;
static_assert(WS_CMAX + (size_t)DEPTH * NGU * 4 <= ZERO_BYTES && WS_RS + (size_t)5 * M * 4 <= WS_SSP && WS_CMAXD + (size_t)DEPTH * D * 4 <= ZERO_BYTES && WS_H8 + (size_t)M * FF <= WS_END && WS_SB + (size_t)(NGU + 2 * D + NIN) * 4 <= WS_WIN && WS_CMAXI + (size_t)DEPTH * NIN * 4 <= ZERO_BYTES && WS_CMAXO + (size_t)DEPTH * D * 4 <= ZERO_BYTES && WS_SSP + (size_t)32 * M * 4 <= WS_SB && WS_SB + (size_t)NGU * 4 <= WS_WIN, "ws map 1");
static_assert(WS_WIN + (size_t)NIN * D * 2 <= WS_WOUT && WS_WOUT + (size_t)D * D * 2 <= WS_WGU && WS_WGU + (size_t)NGU * D <= WS_WD && WS_WD + (size_t)D * FF * 2 <= WS_XB, "ws map 2");
static_assert(WS_XB + (size_t)M * D * 2 <= WS_P && WS_P + (size_t)M * NIN * 2 <= WS_Y && WS_H + (size_t)M * FF * 2 <= WS_Y && WS_Y + (size_t)M * D * 2 <= WS_XQ && WS_XQ + (size_t)M * D <= WS_END, "ws map 3");
constexpr int CW_BAR = 4096;
constexpr int CW_STEAL = 32768;
constexpr int P4_STATIC_STEPS = 30;

constexpr int RING_OFF = 0, RING_BYTES = 131072;
constexpr int LDSCTL_OFF = RING_BYTES, MISC_OFF = LDSCTL_OFF + 320;
constexpr int QKTAB_OFF = RING_BYTES + 1024;
constexpr int LDS_BYTES = 147456;

#define GAS __attribute__((address_space(1)))
#define LAS __attribute__((address_space(3)))
typedef unsigned short bf16;
typedef unsigned v4u __attribute__((ext_vector_type(4)));
typedef unsigned v2u __attribute__((ext_vector_type(2)));
typedef float f32x4 __attribute__((ext_vector_type(4)));
typedef GAS unsigned gu32;
#define RLX_AGENT __ATOMIC_RELAXED, __HIP_MEMORY_SCOPE_AGENT
#define LDS_WAIT() asm volatile("s_waitcnt lgkmcnt(0)" ::: "memory")
#define VM_WAIT() asm volatile("s_waitcnt vmcnt(0)" ::: "memory")
__device__ __forceinline__ unsigned f2bf(float f) { unsigned u = __builtin_bit_cast(unsigned, f); return (u + 0x7fffu + ((u >> 16) & 1u)) >> 16; }
__device__ __forceinline__ unsigned pk2(float lo, float hi) { return f2bf(lo) | (f2bf(hi) << 16); }
__device__ __forceinline__ float bflo(unsigned u) { return __builtin_bit_cast(float, u << 16); }
__device__ __forceinline__ float bfhi(unsigned u) { return __builtin_bit_cast(float, u & 0xffff0000u); }

#define XB_TMO      128
#define XB_XCNT(j)  (256  + 64 * (j))
#define XB_XSUB(j)  (1280 + 64 * (j))
#define XB_XGEN(j)  (2304 + 64 * (j))
#define XB_TOP      3328
#define XB_TOPGEN   3392
#define XCD_BAR_WORDS 3456
#define XB_SPIN_CAP (1u << 23)

__device__ __forceinline__ unsigned xb_ld(unsigned* p)              { return __hip_atomic_load(p, __ATOMIC_RELAXED, __HIP_MEMORY_SCOPE_AGENT); }
__device__ __forceinline__ unsigned xb_add(unsigned* p, unsigned v) { return __hip_atomic_fetch_add(p, v, __ATOMIC_RELAXED, __HIP_MEMORY_SCOPE_AGENT); }
__device__ __forceinline__ unsigned xb_xcc_id() { return (unsigned)__builtin_amdgcn_s_getreg((3 << 11) | 20) & 0xFu; }
#define XB_SPIN(cond, bar) do { unsigned _sp = 0; while (cond) { __builtin_amdgcn_s_sleep(1); \
    if ((++_sp & 255u) == 0u) { if (xb_ld(&(bar)[XB_TMO])) break; if (_sp > XB_SPIN_CAP) { atomicAdd(&(bar)[XB_TMO], 1u); break; } } } } while (0)

struct XcdBarrier { unsigned* bar; unsigned x; volatile LAS unsigned* st; };

__device__ __forceinline__ XcdBarrier xcd_barrier_post(unsigned* bar, volatile LAS unsigned* st, const int wv) {
    XcdBarrier b; b.bar = bar; b.x = xb_xcc_id(); b.st = st;
    if (tid_of(wv) == 0) (void)xb_add(&bar[XB_XCNT(b.x)], 1u);
    return b;
}
__device__ __forceinline__ void xcd_barrier_complete(unsigned* bar, unsigned x, unsigned& nloc, unsigned& nx) {
    const unsigned G = gridDim.x * gridDim.y * gridDim.z;
    unsigned sum, cnt, mine, sp = 0u;
    for (;;) {
        sum = 0u; cnt = 0u; mine = 0u;
#pragma unroll
        for (unsigned j = 0; j < 16; ++j) { const unsigned c = xb_ld(&bar[XB_XCNT(j)]); sum += c; cnt += (c > 0u) ? 1u : 0u; mine = (j == x) ? c : mine; }
        if (sum == G) break;
        __builtin_amdgcn_s_sleep(1);
        if ((++sp & 255u) == 0u) { if (xb_ld(&bar[XB_TMO])) break; if (sp > XB_SPIN_CAP) { atomicAdd(&bar[XB_TMO], 1u); break; } }
    }
    nloc = mine > 0u ? mine : 1u; nx = cnt > 0u ? cnt : 1u;
}
__device__ __forceinline__ void xcd_barrier(const XcdBarrier& b, const int wv) {
    asm volatile("s_waitcnt vmcnt(0)" ::: "memory");
    __syncthreads();
    if (tid_of(wv) == 0) {
        unsigned* bar = b.bar;
        __builtin_amdgcn_s_waitcnt(0);
        unsigned nloc = b.st[0], nx = b.st[1];
        if (nloc == 0u) { xcd_barrier_complete(bar, b.x, nloc, nx); b.st[0] = nloc; b.st[1] = nx; }
        const unsigned old = xb_add(&bar[XB_XSUB(b.x)], 1u);
        const unsigned gen = old / nloc;
        if (old + 1u == (gen + 1u) * nloc) {
            __builtin_amdgcn_fence(__ATOMIC_RELEASE, "agent");
            asm volatile("s_waitcnt vmcnt(0)" ::: "memory");
            const unsigned og = xb_add(&bar[XB_TOP], 1u);
            const unsigned tg = og / nx;
            if (og + 1u == (tg + 1u) * nx) xb_add(&bar[XB_TOPGEN], 1u);
            else XB_SPIN(xb_ld(&bar[XB_TOPGEN]) == tg, bar);
            __builtin_amdgcn_fence(__ATOMIC_ACQUIRE, "agent");
            xb_add(&bar[XB_XGEN(b.x)], 1u);
            asm volatile("s_waitcnt vmcnt(0)" ::: "memory");
        } else {
            XB_SPIN(xb_ld(&bar[XB_XGEN(b.x)]) == gen, bar);
            __builtin_amdgcn_fence(__ATOMIC_ACQUIRE, "agent");
            asm volatile("s_waitcnt vmcnt(0)" ::: "memory");
        }
    }
    __syncthreads();
}

struct Frame {
    LAS unsigned char* lds;
    volatile LAS unsigned* MISC;
    gu32* ctl;
    int tid, lane, wave;
    int vcu, G;
};

__device__ __forceinline__ float wave_sum(float v) {
#pragma unroll
    for (int o = 1; o < 64; o <<= 1) v += __shfl_xor(v, o);
    return v;
}
__device__ __forceinline__ float wave_max(float v) {
#pragma unroll
    for (int o = 1; o < 64; o <<= 1) v = fmaxf(v, __shfl_xor(v, o));
    return v;
}

__device__ __forceinline__ void p0_transpose_item(const float* W, int K, int N, bf16* WT, int k0, int n0, int out_row0, const float* gain, LAS float* scr, int lane) {
    { float tv[32];
#pragma unroll
      for (int i = 0; i < 32; ++i) { const int kk = 2 * i + (lane >> 5); tv[i] = W[(size_t)(k0 + kk) * N + n0 + (lane & 31)]; }
#pragma unroll
      for (int i = 0; i < 32; ++i) { const int kk = 2 * i + (lane >> 5); float v = tv[i]; if (gain) v *= gain[k0 + kk]; scr[kk * 33 + (lane & 31)] = v; } }
    LDS_WAIT(); asm volatile("" ::: "memory");
    const int c = lane & 7;
#pragma unroll
    for (int j = 0; j < 4; ++j) { const int n = (lane >> 3) + 8 * j; const LAS float* s = scr + (8 * c) * 33 + n;
        v4u o; o.x = pk2(s[0 * 33], s[1 * 33]); o.y = pk2(s[2 * 33], s[3 * 33]); o.z = pk2(s[4 * 33], s[5 * 33]); o.w = pk2(s[6 * 33], s[7 * 33]);
        *(GAS v4u*)(WT + (size_t)(out_row0 + n) * K + k0 + 8 * c) = o; }
    LDS_WAIT(); asm volatile("" ::: "memory");
}

template <int N> __device__ __forceinline__ void wht_regs(float (&f)[N]) {
#pragma unroll
    for (int s = 1; s < N; s <<= 1)
#pragma unroll
        for (int i = 0; i < N; ++i) if ((i & s) == 0) { const float a = f[i], b = f[i | s]; f[i] = a + b; f[i | s] = a - b; }
}
__device__ __forceinline__ float dpp_xor1(float v) { return __builtin_bit_cast(float, __builtin_amdgcn_update_dpp(0, __builtin_bit_cast(int, v), 0xB1, 0xF, 0xF, true)); }
__device__ __forceinline__ float dpp_xor2(float v) { return __builtin_bit_cast(float, __builtin_amdgcn_update_dpp(0, __builtin_bit_cast(int, v), 0x4E, 0xF, 0xF, true)); }

__device__ __forceinline__ unsigned q8x4(float a, float b, float c, float d, float inv) {
    const unsigned ua = __builtin_bit_cast(unsigned, fmaf(a, inv, 12582912.0f)), ub = __builtin_bit_cast(unsigned, fmaf(b, inv, 12582912.0f));
    const unsigned uc = __builtin_bit_cast(unsigned, fmaf(c, inv, 12582912.0f)), ud = __builtin_bit_cast(unsigned, fmaf(d, inv, 12582912.0f));
    return __builtin_amdgcn_perm(__builtin_amdgcn_perm(ud, uc, 0x0c0c0400u), __builtin_amdgcn_perm(ub, ua, 0x0c0c0400u), 0x05040100u);
}
__device__ __forceinline__ unsigned q8x4c(float a, float b, float c, float d, float scale) {
    const float lo = 12582912.0f - 127.0f, hi = 12582912.0f + 127.0f;
    const unsigned ua = __builtin_bit_cast(unsigned, fminf(fmaxf(fmaf(a, scale, 12582912.0f), lo), hi)), ub = __builtin_bit_cast(unsigned, fminf(fmaxf(fmaf(b, scale, 12582912.0f), lo), hi));
    const unsigned uc = __builtin_bit_cast(unsigned, fminf(fmaxf(fmaf(c, scale, 12582912.0f), lo), hi)), ud = __builtin_bit_cast(unsigned, fminf(fmaxf(fmaf(d, scale, 12582912.0f), lo), hi));
    return __builtin_amdgcn_perm(__builtin_amdgcn_perm(ud, uc, 0x0c0c0400u), __builtin_amdgcn_perm(ub, ua, 0x0c0c0400u), 0x05040100u);
}
template <bool ROT> __device__ __forceinline__ void p0_q8_item(const float* W, int K, int N, signed char* W8, int k0, int n0, int out_row0, const float* gain, const unsigned* cmax, LAS float* scr, int lane) {
    { float tv[32];
#pragma unroll
      for (int i = 0; i < 32; ++i) { const int kk = 2 * i + (lane >> 5); tv[i] = W[(size_t)(k0 + kk) * N + n0 + (lane & 31)]; }
#pragma unroll
      for (int i = 0; i < 32; ++i) { const int kk = 2 * i + (lane >> 5); float v = tv[i]; if (gain) v *= gain[k0 + kk]; scr[kk * 33 + (lane & 31)] = v; } }
    LDS_WAIT(); asm volatile("" ::: "memory");
    const int n = lane >> 1, half = lane & 1;
    const float cm = __builtin_bit_cast(float, cmax[out_row0 + n]), inv = cm > 0.f ? 127.0f / cm : 0.f;
    const LAS float* s = scr + (32 * half) * 33 + n;
    float vv[32];
#pragma unroll
    for (int j = 0; j < 32; ++j) vv[j] = s[j * 33];
    if (ROT) { wht_regs<32>(vv);
#pragma unroll
        for (int j = 0; j < 32; ++j) vv[j] *= (1.0f / 32.0f); }
    unsigned w[8];
#pragma unroll
    for (int j = 0; j < 8; ++j) w[j] = q8x4(vv[4 * j], vv[4 * j + 1], vv[4 * j + 2], vv[4 * j + 3], inv);
    GAS v4u* dst = (GAS v4u*)(W8 + (size_t)(out_row0 + n) * K + k0 + 32 * half);
    dst[0] = (v4u){w[0], w[1], w[2], w[3]}; dst[1] = (v4u){w[4], w[5], w[6], w[7]};
    LDS_WAIT(); asm volatile("" ::: "memory");
}

__device__ __forceinline__ void pa_colmax(Frame& F, const float* w_gate, const float* w_up, const float* norm2, unsigned* cmax, const float* w_down, unsigned* cmaxd, const float* w_out, const float* aog, const float* cog, unsigned* cmaxo, const float* w_in, const float* norm1, unsigned* cmaxi) {
    const int gw = F.vcu * NWAVES + F.wave, NGW = F.G * NWAVES;
    constexpr int NB = FF / 64, PER_MAT = (D / 64) * NB, NITEMS = DEPTH * 2 * PER_MAT;
    for (int it = gw; it < NITEMS; it += NGW) {
        const int layer = it / (2 * PER_MAT), r0 = it - layer * 2 * PER_MAT, isup = r0 / PER_MAT, r = r0 - isup * PER_MAT, kb = r / NB, nb = r - kb * NB;
        const float* Wp = (isup ? w_up : w_gate) + (size_t)layer * D * FF + (size_t)(64 * kb) * FF + 64 * nb + F.lane;
        const float* gp = norm2 + layer * D + 64 * kb;
        float mx = 0.f;
#pragma unroll 32
        for (int k = 0; k < 64; ++k) mx = fmaxf(mx, fabsf(Wp[(size_t)k * FF] * gp[k]));
        const int n = 64 * nb + F.lane, row = n + (n / 128) * 128 + isup * 128;
        atomicMax(cmax + layer * NGU + row, __builtin_bit_cast(unsigned, mx));
    }
    constexpr int NBD = D / 64, PER_D = (FF / 64) * NBD, NITEMS_D = DEPTH * PER_D;
    for (int it = gw; it < NITEMS_D; it += NGW) {
        const int layer = it / PER_D, r = it - layer * PER_D, kb = r / NBD, nb = r - kb * NBD;
        const float* Wp = w_down + (size_t)layer * FF * D + (size_t)(64 * kb) * D + 64 * nb + F.lane;
        float mx = 0.f;
#pragma unroll
        for (int hb = 0; hb < 2; ++hb) { float vv[32];
#pragma unroll
            for (int k = 0; k < 32; ++k) vv[k] = Wp[(size_t)(32 * hb + k) * D];
            wht_regs<32>(vv);
#pragma unroll
            for (int k = 0; k < 32; ++k) mx = fmaxf(mx, fabsf(vv[k] * (1.0f / 32.0f))); }
        atomicMax(cmaxd + layer * D + 64 * nb + F.lane, __builtin_bit_cast(unsigned, mx));
    }
    constexpr int PER_O = (D / 64) * NBD, NITEMS_O = DEPTH * PER_O;
    for (int it = gw; it < NITEMS_O; it += NGW) {
        const int layer = it / PER_O, r = it - layer * PER_O, kb = r / NBD, nb = r - kb * NBD;
        const float* Wp = w_out + (size_t)layer * D * D + (size_t)(64 * kb) * D + 64 * nb + F.lane;
        const float* gp = (64 * kb < AW) ? aog + layer * AW + 64 * kb : cog + layer * AW + 64 * kb - AW;
        float mx = 0.f;
#pragma unroll
        for (int hb = 0; hb < 2; ++hb) { float vv[32];
#pragma unroll
            for (int k = 0; k < 32; ++k) vv[k] = Wp[(size_t)(32 * hb + k) * D] * gp[32 * hb + k];
            wht_regs<32>(vv);
#pragma unroll
            for (int k = 0; k < 32; ++k) mx = fmaxf(mx, fabsf(vv[k] * (1.0f / 32.0f))); }
        atomicMax(cmaxo + layer * D + 64 * nb + F.lane, __builtin_bit_cast(unsigned, mx));
    }
    constexpr int NBI = NIN / 64, PER_I = (D / 64) * NBI;
    for (int it = gw; it < (DEPTH - P1I8_FROM) * PER_I; it += NGW) {
        const int layer = P1I8_FROM + it / PER_I, r = it % PER_I, kb = r / NBI, nb = r - kb * NBI;
        const float* Wp = w_in + (size_t)layer * D * NIN + (size_t)(64 * kb) * NIN + 64 * nb + F.lane;
        const float* gp = norm1 + layer * D + 64 * kb;
        float mx = 0.f;
#pragma unroll 32
        for (int k = 0; k < 64; ++k) mx = fmaxf(mx, fabsf(Wp[(size_t)k * NIN] * gp[k]));
        atomicMax(cmaxi + layer * NIN + in_dst_col(64 * nb + F.lane), __builtin_bit_cast(unsigned, mx));
    }
}

struct LayerW { const float *norm1, *w_in, *qg, *kg, *rpb, *conv_w, *aog, *cog, *w_out, *norm2, *w_gate, *w_up, *w_down; };

__device__ __forceinline__ void p0_weights(Frame& F, const LayerW& W, bf16* Win_t, signed char* Wout8, signed char* Wgu8, signed char* Wd8, const unsigned* cmax, float* sb, const unsigned* cmaxd, const unsigned* cmaxo, const bool yi8, const unsigned* cmaxi, const bool xi8, const int part) {
    LAS float* scr = (LAS float*)(F.lds + RING_OFF + F.wave * 16384);
    const int gw = F.vcu * NWAVES + F.wave, NGW = F.G * NWAVES;
    constexpr int I_IN = (D / 64) * (NIN / 32), I_OUT = (D / 64) * (D / 32), I_G = (D / 64) * (FF / 32), I_D = (FF / 64) * (D / 32);
    constexpr int NITEMS = I_IN + I_OUT + 2 * I_G + I_D, NA = I_IN + I_OUT + 2 * I_G;
    const int it_lo = (part == 3) ? NA : 0, it_hi = (part == 1) ? NA : (part == 2 ? 0 : NITEMS);
    for (int it = it_lo + gw; it < it_hi; it += NGW) {
        int r = it;
        if (r < I_IN) { const int nblk = NIN / 32, kb = r / nblk, nb = r % nblk; if (xi8) p0_q8_item<false>(W.w_in, D, NIN, (signed char*)Win_t, 64 * kb, 32 * nb, in_dst_col(32 * nb), W.norm1, cmaxi, scr, F.lane); else p0_transpose_item(W.w_in, D, NIN, Win_t, 64 * kb, 32 * nb, in_dst_col(32 * nb), W.norm1, scr, F.lane); continue; } r -= I_IN;
        if (r < I_OUT) { const int nblk = D / 32, kb = r / nblk, nb = r % nblk; if (yi8) p0_q8_item<true>(W.w_out, D, D, Wout8, 64 * kb, 32 * nb, 32 * nb, (64 * kb < AW) ? W.aog : W.cog - AW, cmaxo, scr, F.lane); else p0_transpose_item(W.w_out, D, D, (bf16*)Wout8, 64 * kb, 32 * nb, 32 * nb, nullptr, scr, F.lane); continue; } r -= I_OUT;
        if (r < I_G) { const int nblk = FF / 32, kb = r / nblk, nb = r % nblk, n0 = 32 * nb; p0_q8_item<false>(W.w_gate, D, FF, Wgu8, 64 * kb, n0, n0 + (n0 / 128) * 128, W.norm2, cmax, scr, F.lane); continue; } r -= I_G;
        if (r < I_G) { const int nblk = FF / 32, kb = r / nblk, nb = r % nblk, n0 = 32 * nb; p0_q8_item<false>(W.w_up, D, FF, Wgu8, 64 * kb, n0, n0 + (n0 / 128) * 128 + 128, W.norm2, cmax, scr, F.lane); continue; } r -= I_G;
        { const int nblk = D / 32, kb = r / nblk, nb = r % nblk; p0_q8_item<true>(W.w_down, FF, D, Wd8, 64 * kb, 32 * nb, 32 * nb, nullptr, cmaxd, scr, F.lane); }
    }
    if (part == 1 || part == 3) return;
    if (xi8) for (int i = F.vcu * 512 + F.tid; i < NIN; i += F.G * 512) sb[NGU + 2 * D + i] = __builtin_bit_cast(float, cmaxi[i]) * (1.0f / 127.0f);
    for (int i = F.vcu * 512 + F.tid; i < NGU + 2 * D; i += F.G * 512) sb[i] = __builtin_bit_cast(float, i < NGU ? cmax[i] : (i < NGU + D ? cmaxd[i - NGU] : cmaxo[i - NGU - D])) * (1.0f / 127.0f);
}

__device__ __forceinline__ void p0_x(Frame& F, const float* xp, const float* xs, float* out, bf16* XB, float* ss0) {
    const int gw = F.vcu * NWAVES + F.wave, NGW = F.G * NWAVES;
    for (int m0 = gw; m0 < M; m0 += 2 * NGW) {
        f32x4 v[2][8];
#pragma unroll
        for (int rr = 0; rr < 2; ++rr) { const int m = m0 + rr * NGW;
            const float* src = (m < M_P) ? xp + (size_t)m * D : xs + (size_t)(m - M_P) * D;
            const GAS f32x4* xr = (const GAS f32x4*)src + F.lane;
#pragma unroll
            for (int j = 0; j < 8; ++j) v[rr][j] = xr[64 * j]; }
#pragma unroll
        for (int rr = 0; rr < 2; ++rr) { const int m = m0 + rr * NGW;
            GAS v2u* brow = (GAS v2u*)(XB + (size_t)m * D) + F.lane;
            float s = 0.f;
#pragma unroll
            for (int j = 0; j < 8; ++j) { const f32x4 w = v[rr][j]; s += (w.x * w.x + w.y * w.y) + (w.z * w.z + w.w * w.w);
                v2u b; b.x = pk2(w.x, w.y); b.y = pk2(w.z, w.w); brow[64 * j] = b; }
            s = wave_sum(s);
            if (F.lane == 0) ss0[m] = rsqrtf(s * (1.0f / 2048.0f) + 1e-6f); }
    }
}

__device__ __forceinline__ void reduce_rs(Frame& F, const float* SSP, float* rs) {
    for (int r = F.vcu * 512 + F.tid; r < M; r += F.G * 512) {
        float s = 0.f;
#pragma unroll 8
        for (int j = 0; j < 32; ++j) s += SSP[(size_t)j * M + r];
        rs[r] = rsqrtf(s * (1.0f / 2048.0f) + 1e-6f);
    }
}

__device__ __forceinline__ void r_quant(Frame& F, const float* SSP, const bf16* XB, signed char* XQ, float* rs2, float* rowf) {
    const int gw = F.vcu * NWAVES + F.wave, NGW = F.G * NWAVES, lane = F.lane;
    constexpr int RB = 4;
    for (int m0 = gw; m0 < M; m0 += RB * NGW) {
        v4u v[RB][4];
#pragma unroll
        for (int rr = 0; rr < RB; ++rr) { const int m = m0 + rr * NGW; const bool ok = m < M; const int mc = ok ? m : gw;
            const GAS v4u* xr = (const GAS v4u*)(XB + (size_t)mc * D) + lane;
#pragma unroll
            for (int j = 0; j < 4; ++j) v[rr][j] = xr[64 * j]; }
#pragma unroll
        for (int rr = 0; rr < RB; ++rr) { const int m = m0 + rr * NGW; if (m >= M) break;
            float f[4][8]; float mx = 0.f, sq = 0.f;
#pragma unroll
            for (int j = 0; j < 4; ++j) { f[j][0] = bflo(v[rr][j].x); f[j][1] = bfhi(v[rr][j].x); f[j][2] = bflo(v[rr][j].y); f[j][3] = bfhi(v[rr][j].y); f[j][4] = bflo(v[rr][j].z); f[j][5] = bfhi(v[rr][j].z); f[j][6] = bflo(v[rr][j].w); f[j][7] = bfhi(v[rr][j].w);
#pragma unroll
                for (int e = 0; e < 8; ++e) { mx = fmaxf(mx, fabsf(f[j][e])); sq += f[j][e] * f[j][e]; } }
            mx = wave_max(mx);
            const float rstd = rsqrtf(wave_sum(sq) * (1.0f / 2048.0f) + 1e-6f);
            const float inv = mx > 0.f ? 127.0f / mx : 0.f;
            GAS v2u* qr = (GAS v2u*)(XQ + (size_t)m * D) + lane;
#pragma unroll
            for (int j = 0; j < 4; ++j) qr[64 * j] = (v2u){q8x4(f[j][0], f[j][1], f[j][2], f[j][3], inv), q8x4(f[j][4], f[j][5], f[j][6], f[j][7], inv)};
            if (lane == 0) { rs2[m] = rstd; rowf[m] = mx * (1.0f / 127.0f) * rstd; }
        }
    }
}

__device__ __forceinline__ void h_quant_row(const v4u (&v)[11], const int m, const int lane, const float s1, const float s2, signed char* H8, float* hs) {
    float f[11][8]; float mx = 0.f;
#pragma unroll
    for (int j = 0; j < 11; ++j) {
        f[j][0] = bflo(v[j].x); f[j][1] = bfhi(v[j].x); f[j][2] = bflo(v[j].y); f[j][3] = bfhi(v[j].y); f[j][4] = bflo(v[j].z); f[j][5] = bfhi(v[j].z); f[j][6] = bflo(v[j].w); f[j][7] = bfhi(v[j].w);
        wht_regs<8>(f[j]);
#pragma unroll
        for (int e = 0; e < 8; ++e) { const float p = dpp_xor1(f[j][e]); f[j][e] = fmaf(f[j][e], s1, p); }
#pragma unroll
        for (int e = 0; e < 8; ++e) { const float p = dpp_xor2(f[j][e]); f[j][e] = fmaf(f[j][e], s2, p); mx = fmaxf(mx, fabsf(f[j][e])); }
    }
    mx = wave_max(mx);
    const float inv = mx > 0.f ? 127.0f / mx : 0.f;
    GAS v2u* qr = (GAS v2u*)(H8 + (size_t)m * FF) + lane;
#pragma unroll
    for (int j = 0; j < 11; ++j) qr[64 * j] = (v2u){q8x4(f[j][0], f[j][1], f[j][2], f[j][3], inv), q8x4(f[j][4], f[j][5], f[j][6], f[j][7], inv)};
    if (lane == 0) hs[m] = mx * (1.0f / 127.0f);
}
__device__ __forceinline__ void h_quant(Frame& F, const bf16* H, signed char* H8, float* hs) {
    const int gw = F.vcu * NWAVES + F.wave, NGW = F.G * NWAVES, lane = F.lane;
    const float s1 = (lane & 1) ? -1.0f : 1.0f, s2 = (lane & 2) ? -1.0f : 1.0f;
#define HQ_LOAD(v, m_) do { const GAS v4u* hr_ = (const GAS v4u*)(H + (size_t)(m_) * FF) + lane; _Pragma("unroll") for (int j = 0; j < 11; ++j) v[j] = hr_[64 * j]; } while (0)
    v4u va[11], vb[11];
    const int NK = M / NGW;
#define HQ_ROW(k_) ([&](const int kk) { const int i_ = (kk & 3) * NGW + gw, g_ = 5 - (kk >> 2); return 6144 * (i_ >> 10) + 1024 * g_ + (i_ & 1023); }(k_))
    const bool remap = (NGW == 2048);
    HQ_LOAD(va, remap ? HQ_ROW(0) : gw);
    for (int k = 0; k < NK; k += 2) {
        const int m0 = remap ? HQ_ROW(k) : gw + k * NGW, m1 = remap ? HQ_ROW(k + 1) : gw + (k + 1) * NGW, m2 = (k + 2 < NK) ? (remap ? HQ_ROW(k + 2) : gw + (k + 2) * NGW) : m0;
        HQ_LOAD(vb, m1);
        h_quant_row(va, m0, lane, s1, s2, H8, hs);
        if (k + 2 < NK) HQ_LOAD(va, m2);
        h_quant_row(vb, m1, lane, s1, s2, H8, hs);
    }
#undef HQ_ROW
#undef HQ_LOAD
}

__device__ __forceinline__ void seq_of(int t, int& base, int& L) {
    if (t < M_P) { L = 16384; base = (t >> 14) << 14; } else { L = 8192; base = M_P + (((t - M_P) >> 13) << 13); }
}

namespace att {
typedef short bf16x8 __attribute__((ext_vector_type(8)));
typedef short s16x4 __attribute__((ext_vector_type(4)));
typedef short v4i16_t __attribute__((ext_vector_type(4)));
constexpr int PAIRB = 32768, NPAIR = 4, RPB_OFF = QKTAB_OFF, RPB_ROWS = 17, GAIN_OFF = RPB_OFF + RPB_ROWS * 128, RED_OFF = GAIN_OFF + 512, UPW = 6;
constexpr float LOG2E = 1.4426950408889634f;
struct UnitGeo { int base, rows, r0, j0, nr; };
__device__ __forceinline__ int clampi(int x, int lo, int hi) { return x < lo ? lo : (x > hi ? hi : x); }
__device__ __forceinline__ UnitGeo unit_geo(int vcu, int ui) {
    UnitGeo g; const int gp = ui * 32 + (vcu >> 3); int rq;
    if (gp < 128) { rq = gp & 63; g.rows = 256; g.base = (gp >> 6) * 16384; }
    else { const int q = gp - 128; rq = q & 31; g.rows = 128; g.base = M_P + (q >> 5) * 8192; }
    g.r0 = 4 * rq;
    const int a = clampi(g.r0 - 4, 0, g.rows - 8), b = clampi(g.r0 - 1, 0, g.rows - 8);
    g.j0 = a; g.nr = b + 8 - a;
    return g;
}
__device__ __forceinline__ void glds16(const void* gsrc, unsigned lds_dst) { unsigned keep;
    asm volatile("s_mov_b32 %0, m0\n\ts_mov_b32 m0, %2\n\ts_nop 0\n\tglobal_load_lds_dwordx4 %1, off\n\ts_mov_b32 m0, %0" : "=&s"(keep) : "v"(gsrc), "s"(lds_dst) : "memory"); }
__device__ __forceinline__ s16x4 vtr(unsigned addr) { return __builtin_bit_cast(s16x4, __builtin_amdgcn_ds_read_tr16_b64_v4i16((LAS v4i16_t*)(size_t)addr)); }

__device__ __forceinline__ void attention(LAS unsigned char* lds, const bf16* P, signed char* Y, const float* rpb, const float* aog, const float* qg, const float* kg, const bool yi8, int vcu, const int wv) {
    int tid_ = tid_of(wv); asm volatile("" : "+v"(tid_));
    const int tid = tid_, wave = __builtin_amdgcn_readfirstlane(tid >> 6), lane = tid & 63, q = lane & 15, g = lane >> 4;
    const int n = wave & 3, grp = wave >> 2, h = vcu & 7;
    const unsigned ldsb = (unsigned)(size_t)lds;
    LAS float* red = (LAS float*)(lds + RED_OFF);
    { float mb = 0.f, mq = 0.f, mk = 0.f;
      for (int i = tid; i < 15 * 31; i += 512) mb = fmaxf(mb, fabsf(rpb[h * 15 * 31 + i]));
      if (tid < HD) { mq = fabsf(qg[tid]); mk = fabsf(kg[tid]); }
#pragma unroll
      for (int o = 1; o < 64; o <<= 1) { mb = fmaxf(mb, __shfl_xor(mb, o)); mq = fmaxf(mq, __shfl_xor(mq, o)); mk = fmaxf(mk, __shfl_xor(mk, o)); }
      if (lane == 0) { red[wave * 4 + 0] = mb; red[wave * 4 + 1] = mq; red[wave * 4 + 2] = mk; } }
    __syncthreads();
    float shift;
    { float mb = 0.f, mq = 0.f, mk = 0.f;
#pragma unroll
      for (int w = 0; w < 8; ++w) { mb = fmaxf(mb, red[w * 4 + 0]); mq = fmaxf(mq, red[w * 4 + 1]); mk = fmaxf(mk, red[w * 4 + 2]); }
      shift = fminf(64.0f, mq * mk * (11.313708498984761f * LOG2E * 1.01f) + mb * LOG2E + 0.25f); }
    LAS float* rt = (LAS float*)(lds + RPB_OFF);
    for (int i = tid; i < RPB_ROWS * 32; i += 512) { const int rr = i >> 5, cc = i & 31; float v = -1e30f;
        if (rr >= 1 && rr <= 15 && cc < 31) v = rpb[(h * 15 + rr - 1) * 31 + cc] * LOG2E - shift; rt[i] = v; }
    if (!yi8 && tid < HD) ((LAS float*)(lds + GAIN_OFF))[tid] = aog[h * HD + tid];
    const int bs = (n == 0) ? 0 : (n == 1 ? 8 : (n == 2 ? 24 : 32));
    const int c = 16 * n + q, cs = clampi(c - 8, 0, 48);
    const int kpg = (g == 0) ? 0 : (g == 1 ? 2 : (g == 2 ? 3 : 1)), qa = q >> 2, pq = (qa == 0) ? 0 : (qa == 1 ? 2 : (qa == 2 ? 3 : 1));
    unsigned ci[2][4];
#pragma unroll
    for (int hf = 0; hf < 2; ++hf)
#pragma unroll
        for (int rg = 0; rg < 4; ++rg) { const int kc = bs + 16 * hf + 4 * kpg + rg; const bool cvv = (kc >= cs) && (kc < cs + 16); ci[hf][rg] = ldsb + RPB_OFF + (unsigned)((cvv ? clampi(kc - c + 15, 0, 30) : 31) * 4); }
    unsigned koff[2], kx[2];
#pragma unroll
    for (int hf = 0; hf < 2; ++hf) { const unsigned rowk = bs + 16 * hf + 4 * pq + (q & 3); koff[hf] = 256u * rowk + 16u * (g ^ ((rowk >> 2) & 3u)); kx[hf] = rowk & 3u; }
    const unsigned qp = q >> 2, pp = q & 3;
    unsigned voff[2], vfx[2];
#pragma unroll
    for (int t = 0; t < 2; ++t) { const unsigned rowv = bs + 16 * t + 4 * kpg + qp, f = ((rowv & 3u) << 2) | ((rowv >> 2) & 3u);
        voff[t] = 16384u + 256u * rowv + 8u * (pp & 1u) + 16u * ((pp >> 1) ^ (f & 1u)); vfx[t] = f & 14u; }
    unsigned goff[2];
#pragma unroll
    for (int i = 0; i < 2; ++i) { const unsigned pos = i * 512 + tid, row = pos >> 4, pch = pos & 15u, ch = pch ^ (((row & 3u) << 2) | ((row >> 2) & 3u)); goff[i] = row * (unsigned)(PW * 2) + ch * 16u; }
    __syncthreads();
    int pu = 0, pt = 0, issued = 0, consumed = 0, islot = 0, cslot = 0; UnitGeo pg = unit_geo(vcu, 0);
#define ATT_ISSUE() do { if (pu < UPW) { \
        const char* gp_ = (const char*)P + ((size_t)(pg.base + (pg.j0 + pt) * 64) * PW + AW + h * HD) * 2; const unsigned ld_ = ldsb + (unsigned)(islot * PAIRB + wave * 1024); \
        glds16(gp_ + goff[0], ld_); glds16(gp_ + goff[1], ld_ + 8192u); glds16(gp_ + 2 * AW + goff[0], ld_ + 16384u); glds16(gp_ + 2 * AW + goff[1], ld_ + 24576u); \
        ++issued; islot = (islot + 1) & (NPAIR - 1); if (++pt == pg.nr) { pt = 0; if (++pu < UPW) pg = unit_geo(vcu, pu); } } } while (0)
#define ATT_SYNC(qadd_) do { const int nv_ = 4 * (issued - consumed - 1) + (qadd_); \
        if (nv_ >= 16) asm volatile("s_waitcnt vmcnt(16)" ::: "memory"); else if (nv_ == 12) asm volatile("s_waitcnt vmcnt(12)" ::: "memory"); else if (nv_ == 8) asm volatile("s_waitcnt vmcnt(8)" ::: "memory"); \
        else if (nv_ == 4) asm volatile("s_waitcnt vmcnt(4)" ::: "memory"); else asm volatile("s_waitcnt vmcnt(0)" ::: "memory"); \
        asm volatile("s_waitcnt lgkmcnt(0)" ::: "memory"); __builtin_amdgcn_s_barrier(); asm volatile("" ::: "memory"); \
        slotb = ldsb + (unsigned)(cslot * PAIRB); cslot = (cslot + 1) & (NPAIR - 1); ++consumed; } while (0)
    ATT_ISSUE(); ATT_ISSUE(); ATT_ISSUE();
    unsigned slotb = 0;
    bf16x8 qn[2][4];
    { const UnitGeo G0 = unit_geo(vcu, 0);
#pragma unroll
      for (int rr = 0; rr < 2; ++rr) { const bf16* qptr = P + (size_t)(G0.base + (G0.r0 + 2 * grp + rr) * 64 + c) * PW + h * HD + 8 * g;
#pragma unroll
          for (int ks = 0; ks < 4; ++ks) qn[rr][ks] = *(const GAS bf16x8*)(qptr + 32 * ks); }
      asm volatile("" : "+v"(qn[0][0]), "+v"(qn[0][1]), "+v"(qn[0][2]), "+v"(qn[0][3]), "+v"(qn[1][0]), "+v"(qn[1][1]), "+v"(qn[1][2]), "+v"(qn[1][3])); }
    for (int ui = 0; ui < UPW; ++ui) {
        const UnitGeo G = unit_geo(vcu, ui);
        const int ra = G.r0 + 2 * grp;
        int offd[2], tq[2]; unsigned tb[2];
#pragma unroll
        for (int rr = 0; rr < 2; ++rr) { offd[rr] = clampi(ra + rr - 4, 0, G.rows - 8) - G.j0; tq[rr] = G.base + (ra + rr) * 64 + c; tb[rr] = (unsigned)((G.j0 - (ra + rr) + 8) * 128); }
        bf16x8 qf[2][4];
#pragma unroll
        for (int rr = 0; rr < 2; ++rr)
#pragma unroll
            for (int ks = 0; ks < 4; ++ks) qf[rr][ks] = qn[rr][ks];
        f32x4 O[2][8]; float sum[2] = {0.f, 0.f};
#pragma unroll
        for (int rr = 0; rr < 2; ++rr)
#pragma unroll
            for (int c2 = 0; c2 < 8; ++c2) O[rr][c2] = (f32x4){0.f, 0.f, 0.f, 0.f};
        const bool qnext = ui + 1 < UPW;
#pragma unroll 1
        for (int jj = 0; jj < G.nr; ++jj) {
            ATT_SYNC((qnext && jj >= 4 && jj <= 6) ? 8 : 0);
            ATT_ISSUE();
            if (jj == 3 && qnext) {
                const UnitGeo Gn = unit_geo(vcu, ui + 1);
#pragma unroll
                for (int rr = 0; rr < 2; ++rr) { const bf16* qptr = P + (size_t)(Gn.base + (Gn.r0 + 2 * grp + rr) * 64 + c) * PW + h * HD + 8 * g;
#pragma unroll
                    for (int ks = 0; ks < 4; ++ks) asm volatile("global_load_dwordx4 %0, %1, off" : "=&v"(qn[rr][ks]) : "v"(qptr + 32 * ks) : "memory"); } }
            const bool v0 = (jj >= offd[0]) && (jj < offd[0] + 8), v1 = (jj >= offd[1]) && (jj < offd[1] + 8);
            if (v0 || v1) {
                bf16x8 kf[2][4]; float bb[2][8];
#pragma unroll
                for (int hf = 0; hf < 2; ++hf)
#pragma unroll
                    for (int ks = 0; ks < 4; ++ks) kf[hf][ks] = *(const LAS bf16x8*)(size_t)(slotb + koff[hf] + 64u * ((unsigned)ks ^ kx[hf]));
                const unsigned tr0 = v0 ? tb[0] + (unsigned)(jj * 128) : 0u, tr1 = v1 ? tb[1] + (unsigned)(jj * 128) : 0u;
#pragma unroll
                for (int hf = 0; hf < 2; ++hf)
#pragma unroll
                    for (int rg = 0; rg < 4; ++rg) { bb[0][hf * 4 + rg] = *(const LAS float*)(size_t)(ci[hf][rg] + tr0); bb[1][hf * 4 + rg] = *(const LAS float*)(size_t)(ci[hf][rg] + tr1); }
                asm volatile("" : "+v"(kf[0][0]), "+v"(kf[0][1]), "+v"(kf[0][2]), "+v"(kf[0][3]), "+v"(kf[1][0]), "+v"(kf[1][1]), "+v"(kf[1][2]), "+v"(kf[1][3]));
                f32x4 S[2][2];
#pragma unroll
                for (int rr = 0; rr < 2; ++rr) { S[rr][0] = (f32x4){0.f, 0.f, 0.f, 0.f}; S[rr][1] = (f32x4){0.f, 0.f, 0.f, 0.f}; }
#pragma unroll
                for (int ks = 0; ks < 4; ++ks)
#pragma unroll
                    for (int hf = 0; hf < 2; ++hf)
#pragma unroll
                        for (int rr = 0; rr < 2; ++rr) S[rr][hf] = __builtin_amdgcn_mfma_f32_16x16x32_bf16(kf[hf][ks], qf[rr][ks], S[rr][hf], 0, 0, 0);
                bf16x8 vb[8];
#pragma unroll
                for (int c2 = 0; c2 < 8; ++c2) { const s16x4 a0 = vtr(slotb + voff[0] + 16u * ((unsigned)(2 * c2) ^ vfx[0])), a1 = vtr(slotb + voff[1] + 16u * ((unsigned)(2 * c2) ^ vfx[1]));
                    vb[c2] = (bf16x8){a0[0], a0[1], a0[2], a0[3], a1[0], a1[1], a1[2], a1[3]}; }
                __builtin_amdgcn_sched_barrier(0);
                asm volatile("" : "+v"(bb[0][0]), "+v"(bb[0][1]), "+v"(bb[0][2]), "+v"(bb[0][3]), "+v"(bb[0][4]), "+v"(bb[0][5]), "+v"(bb[0][6]), "+v"(bb[0][7]),
                                  "+v"(bb[1][0]), "+v"(bb[1][1]), "+v"(bb[1][2]), "+v"(bb[1][3]), "+v"(bb[1][4]), "+v"(bb[1][5]), "+v"(bb[1][6]), "+v"(bb[1][7]));
                bf16x8 pf[2];
#pragma unroll
                for (int rr = 0; rr < 2; ++rr) { float e[8];
#pragma unroll
                    for (int hf = 0; hf < 2; ++hf)
#pragma unroll
                        for (int rg = 0; rg < 4; ++rg) { e[hf * 4 + rg] = __builtin_amdgcn_exp2f(S[rr][hf][rg] + bb[rr][hf * 4 + rg]); sum[rr] += e[hf * 4 + rg]; }
                    pg8::u32x4 w; w.x = pg8::cvt_pk_bf16(e[0], e[1]); w.y = pg8::cvt_pk_bf16(e[2], e[3]); w.z = pg8::cvt_pk_bf16(e[4], e[5]); w.w = pg8::cvt_pk_bf16(e[6], e[7]);
                    pf[rr] = __builtin_bit_cast(bf16x8, w); }
                __builtin_amdgcn_sched_barrier(0);
                asm volatile("" : "+v"(vb[0]), "+v"(vb[1]), "+v"(vb[2]), "+v"(vb[3]), "+v"(vb[4]), "+v"(vb[5]), "+v"(vb[6]), "+v"(vb[7]));
#pragma unroll
                for (int c2 = 0; c2 < 8; ++c2)
#pragma unroll
                    for (int rr = 0; rr < 2; ++rr) O[rr][c2] = __builtin_amdgcn_mfma_f32_16x16x32_bf16(vb[c2], pf[rr], O[rr][c2], 0, 0, 0);
            }
        }
        asm volatile("" : "+v"(qn[0][0]), "+v"(qn[0][1]), "+v"(qn[0][2]), "+v"(qn[0][3]), "+v"(qn[1][0]), "+v"(qn[1][1]), "+v"(qn[1][2]), "+v"(qn[1][3]));
#pragma unroll
        for (int rr = 0; rr < 2; ++rr) {
        float sm = sum[rr]; sm += __shfl_xor(sm, 16); sm += __shfl_xor(sm, 32);
        const float inv = 1.0f / sm;
        float ssq = 0.f;
#pragma unroll
        for (int c2 = 0; c2 < 8; ++c2) { const f32x4 o = O[rr][c2] * inv; O[rr][c2] = o; ssq += (o[0] * o[0] + o[1] * o[1]) + (o[2] * o[2] + o[3] * o[3]); }
        ssq += __shfl_xor(ssq, 16); ssq += __shfl_xor(ssq, 32);
        const float rn = rsqrtf(ssq * (1.0f / 128.0f) + 1e-6f);
        if (!yi8) {
            bf16* ypb = (bf16*)Y + (size_t)tq[rr] * D + h * HD + 4 * g; const unsigned gb = ldsb + GAIN_OFF + (unsigned)((4 * g) * 4);
#pragma unroll
            for (int c2 = 0; c2 < 8; ++c2) { const f32x4 gv = *(const LAS f32x4*)(size_t)(gb + 64 * c2);
                v2u w; w.x = pg8::cvt_pk_bf16(O[rr][c2][0] * rn * gv[0], O[rr][c2][1] * rn * gv[1]); w.y = pg8::cvt_pk_bf16(O[rr][c2][2] * rn * gv[2], O[rr][c2][3] * rn * gv[3]);
                *(GAS v2u*)(ypb + 16 * c2) = w; }
        } else {
        float yv[8][4];
#pragma unroll
        for (int c2 = 0; c2 < 8; ++c2) { const float a = O[rr][c2][0] * rn, b = O[rr][c2][1] * rn, cc_ = O[rr][c2][2] * rn, d = O[rr][c2][3] * rn;
            const float s0 = a + b, s1 = a - b, s2 = cc_ + d, s3 = cc_ - d; yv[c2][0] = s0 + s2; yv[c2][1] = s1 + s3; yv[c2][2] = s0 - s2; yv[c2][3] = s1 - s3; }
#pragma unroll
        for (int bq = 0; bq < 4; ++bq)
#pragma unroll
            for (int rg = 0; rg < 4; ++rg) { const float x0 = yv[2 * bq][rg], x1 = yv[2 * bq + 1][rg]; yv[2 * bq][rg] = x0 + x1; yv[2 * bq + 1][rg] = x0 - x1; }
        const bool g0 = (g & 1) != 0, g1 = (g & 2) != 0;
        signed char* yp = Y + (size_t)tq[rr] * D + h * HD + 4 * g;
#pragma unroll
        for (int c2 = 0; c2 < 8; ++c2) { float vq[4];
#pragma unroll
            for (int rg = 0; rg < 4; ++rg) { float v = yv[c2][rg]; float p = __shfl_xor(v, 16); v = g0 ? p - v : v + p; p = __shfl_xor(v, 32); vq[rg] = g1 ? p - v : v + p; }
            *(GAS unsigned*)(yp + 16 * c2) = q8x4c(vq[0], vq[1], vq[2], vq[3], YQ); }
        }
        }
    }
    asm volatile("s_waitcnt vmcnt(0) lgkmcnt(0)" ::: "memory"); __builtin_amdgcn_s_barrier(); asm volatile("" ::: "memory");
#undef ATT_ISSUE
#undef ATT_SYNC
}
}

__device__ __forceinline__ void p2_conv(Frame& F, const bf16* P, signed char* Y, const float* conv_w, const float* cog, const bool yi8) {
    const int gw = F.vcu * NWAVES + F.wave, NGW = F.G * NWAVES, lane = F.lane;
    const int ch = (gw & 1) * 512 + 8 * lane;
    float w[3][8], gn[8]; const float s1 = (lane & 1) ? -1.0f : 1.0f, s2 = (lane & 2) ? -1.0f : 1.0f;
    { const f32x4 a = *(const GAS f32x4*)(cog + ch), b = *(const GAS f32x4*)(cog + ch + 4); gn[0] = a[0]; gn[1] = a[1]; gn[2] = a[2]; gn[3] = a[3]; gn[4] = b[0]; gn[5] = b[1]; gn[6] = b[2]; gn[7] = b[3]; }
#pragma unroll
    for (int j = 0; j < 3; ++j) { const f32x4 a = *(const GAS f32x4*)(conv_w + j * AW + ch), b = *(const GAS f32x4*)(conv_w + j * AW + ch + 4);
        w[j][0] = a[0]; w[j][1] = a[1]; w[j][2] = a[2]; w[j][3] = a[3]; w[j][4] = b[0]; w[j][5] = b[1]; w[j][6] = b[2]; w[j][7] = b[3]; }
#define CV_LOAD(cc, bb, it_) do { const int t0_ = ((it_) >> 1) * 4; int base_, L_; seq_of(t0_, base_, L_); const int tl_ = t0_ - base_; \
        _Pragma("unroll") for (int j = 0; j < 6; ++j) { const int tt_ = tl_ + j - 1; const bool ok_ = (tt_ >= 0) && (tt_ < L_); cc[j] = *(const GAS v4u*)(P + (size_t)(base_ + (ok_ ? tt_ : tl_)) * PW + 4 * AW + ch); } \
        _Pragma("unroll") for (int i = 0; i < 4; ++i) bb[i] = *(const GAS v4u*)(P + (size_t)(t0_ + i) * PW + 3 * AW + ch); } while (0)
    auto compute = [&](const v4u (&cc)[6], const v4u (&bb)[4], const int it) {
        const int t0 = (it >> 1) * 4;
        int base, L; seq_of(t0, base, L);
        const int tl = t0 - base;
        float cu[6][8];
#pragma unroll
        for (int j = 0; j < 6; ++j) { const int tt = tl + j - 1; const bool ok = (tt >= 0) && (tt < L);
            const v4u c = ok ? cc[j] : (v4u){0u, 0u, 0u, 0u};
            cu[j][0] = bflo(c.x); cu[j][1] = bfhi(c.x); cu[j][2] = bflo(c.y); cu[j][3] = bfhi(c.y); cu[j][4] = bflo(c.z); cu[j][5] = bfhi(c.z); cu[j][6] = bflo(c.w); cu[j][7] = bfhi(c.w); }
#pragma unroll
        for (int i = 0; i < 4; ++i) {
            const float bv[8] = {bflo(bb[i].x), bfhi(bb[i].x), bflo(bb[i].y), bfhi(bb[i].y), bflo(bb[i].z), bfhi(bb[i].z), bflo(bb[i].w), bfhi(bb[i].w)};
            float y[8]; float s = 0.f;
#pragma unroll
            for (int e = 0; e < 8; ++e) { y[e] = bv[e] * (w[0][e] * cu[i][e] + w[1][e] * cu[i + 1][e] + w[2][e] * cu[i + 2][e]); s += y[e] * y[e]; }
            s += __shfl_xor(s, 1); s += __shfl_xor(s, 2); s += __shfl_xor(s, 4); s += __shfl_xor(s, 8);
            const float rn = rsqrtf(s * (1.0f / 128.0f) + 1e-6f);
            if (!yi8) { v4u o; o.x = pk2(y[0] * rn * gn[0], y[1] * rn * gn[1]); o.y = pk2(y[2] * rn * gn[2], y[3] * rn * gn[3]); o.z = pk2(y[4] * rn * gn[4], y[5] * rn * gn[5]); o.w = pk2(y[6] * rn * gn[6], y[7] * rn * gn[7]);
                *(GAS v4u*)((bf16*)Y + (size_t)(t0 + i) * D + AW + ch) = o; continue; }
#pragma unroll
            for (int e = 0; e < 8; ++e) y[e] *= rn;
            wht_regs<8>(y);
#pragma unroll
            for (int e = 0; e < 8; ++e) { float v = y[e]; float p = dpp_xor1(v); v = fmaf(v, s1, p); p = dpp_xor2(v); y[e] = fmaf(v, s2, p); }
            *(GAS v2u*)(Y + (size_t)(t0 + i) * D + AW + ch) = (v2u){q8x4c(y[0], y[1], y[2], y[3], YQ), q8x4c(y[4], y[5], y[6], y[7], YQ)};
        }
    };
    constexpr int NI = M / 2;
    v4u ca[6], ba[4], cb[6], bq[4];
    if (gw < NI) CV_LOAD(ca, ba, gw);
    for (int it = gw; it < NI; it += 2 * NGW) {
        const int i1 = it + NGW, i2 = i1 + NGW;
        if (i1 < NI) CV_LOAD(cb, bq, i1);
        compute(ca, ba, it);
        if (i1 >= NI) break;
        if (i2 < NI) CV_LOAD(ca, ba, i2);
        compute(cb, bq, i1);
    }
#undef CV_LOAD
}

struct Args { const float* in[15]; float* out; unsigned char* ws; int ph_lo, ph_hi, li, pad; };
constexpr int PH_PER_LAYER = 8, N_PHASES = 1 + DEPTH * PH_PER_LAYER;
typedef __attribute__((address_space(4))) const unsigned long long kau64;
__device__ __forceinline__ kau64* karg() { kau64* p = (kau64*)__builtin_amdgcn_kernarg_segment_ptr(); asm volatile("" : "+s"(p)); return p; }
#define KA_IN(ka, i) ((const float*)(const GAS float*)(ka)[i])
#define KA_OUT(ka) ((float*)(GAS float*)(ka)[15])
#define KA_WS(ka) ((unsigned char*)(GAS unsigned char*)(ka)[16])
#define KA_LO(ka) ((int)(unsigned)((ka)[17] & 0xffffffffull))
#define KA_HI(ka) ((int)(unsigned)((ka)[17] >> 32))

__device__ __forceinline__ int opaque_bx() { int bx = blockIdx.x; asm volatile("" : "+s"(bx)); return bx; }
__device__ __forceinline__ Frame make_frame(LAS unsigned char* lds, const int wv) {
    Frame F; F.lds = lds; F.MISC = (volatile LAS unsigned*)(lds + MISC_OFF);
    { int t_ = tid_of(wv); asm volatile("" : "+v"(t_)); F.tid = t_; } F.lane = F.tid & 63; F.wave = __builtin_amdgcn_readfirstlane(F.tid >> 6);
    F.G = gridDim.x; { int bx = blockIdx.x; asm volatile("" : "+s"(bx)); F.vcu = (F.G % 8 == 0) ? (bx % 8) * (F.G / 8) + bx / 8 : bx; }
    F.ctl = nullptr; return F;
}
__device__ __forceinline__ LayerW make_lw(kau64* ka, int layer) {
    LayerW W;
    W.norm1 = KA_IN(ka, 2) + (size_t)layer * D; W.w_in = KA_IN(ka, 3) + (size_t)layer * D * NIN; W.qg = KA_IN(ka, 4) + layer * HD; W.kg = KA_IN(ka, 5) + layer * HD;
    W.rpb = KA_IN(ka, 6) + (size_t)layer * NH * 15 * 31; W.conv_w = KA_IN(ka, 7) + (size_t)layer * 3 * AW; W.aog = KA_IN(ka, 8) + layer * AW; W.cog = KA_IN(ka, 9) + layer * AW;
    W.w_out = KA_IN(ka, 10) + (size_t)layer * D * D; W.norm2 = KA_IN(ka, 11) + (size_t)layer * D;
    W.w_gate = KA_IN(ka, 12) + (size_t)layer * D * FF; W.w_up = KA_IN(ka, 13) + (size_t)layer * D * FF; W.w_down = KA_IN(ka, 14) + (size_t)layer * FF * D;
    return W;
}
__device__ __forceinline__ void seam(LAS unsigned char* lds, int k, const int wv) {
    kau64* ka = karg();
    if (!(KA_LO(ka) <= k + 1 && k + 1 < KA_HI(ka))) return;
    XcdBarrier b; b.bar = (unsigned*)(KA_WS(ka) + WS_CTL) + CW_BAR; b.x = xb_xcc_id(); b.st = (volatile LAS unsigned*)(lds + MISC_OFF) + 8;
    xcd_barrier(b, wv);
}
__device__ __forceinline__ bool in_range(int k) { kau64* ka = karg(); return KA_LO(ka) <= k && k < KA_HI(ka); }

__global__ void __launch_bounds__(NWAVES * 64, 2) enc_fwd(Args args) {
    extern __shared__ __attribute__((aligned(16))) unsigned char lds_raw[];
    LAS unsigned char* lds = (LAS unsigned char*)lds_raw;
    const int wv = __builtin_amdgcn_readfirstlane((int)threadIdx.x >> 6);
    for (int u = tid_of(wv); u < (LDS_BYTES - LDSCTL_OFF) / 4; u += NWAVES * 64) ((LAS unsigned*)(lds + LDSCTL_OFF))[u] = 0u;
    __syncthreads();
    { kau64* ka = karg(); (void)xcd_barrier_post((unsigned*)(KA_WS(ka) + WS_CTL) + CW_BAR, (volatile LAS unsigned*)(lds + MISC_OFF) + 8, wv); }

    if (in_range(0)) {
        kau64* ka = karg(); unsigned char* ws = KA_WS(ka); Frame F = make_frame(lds, wv);
        for (int rep = 0; rep < DUPN(32); ++rep) pa_colmax(F, KA_IN(ka, 12), KA_IN(ka, 13), KA_IN(ka, 11), (unsigned*)(ws + WS_CMAX), KA_IN(ka, 14), (unsigned*)(ws + WS_CMAXD), KA_IN(ka, 10), KA_IN(ka, 8), KA_IN(ka, 9), (unsigned*)(ws + WS_CMAXO), KA_IN(ka, 3), KA_IN(ka, 2), (unsigned*)(ws + WS_CMAXI));
        __syncthreads();
        seam(lds, 0, wv);
    }
    for (int layer = 0; layer < DEPTH; ++layer) {
        const int pb = 1 + layer * PH_PER_LAYER;
        if (in_range(pb + 0)) {
            kau64* ka = karg(); unsigned char* ws = KA_WS(ka); Frame F = make_frame(lds, wv); const LayerW W = make_lw(ka, layer);
            if (layer == 0) p0_weights(F, W, (bf16*)(ws + WS_WIN), (signed char*)(ws + WS_WOUT), (signed char*)(ws + WS_WGU), (signed char*)(ws + WS_WD), (const unsigned*)(ws + WS_CMAX) + layer * NGU, (float*)(ws + WS_SB), (const unsigned*)(ws + WS_CMAXD) + layer * D, (const unsigned*)(ws + WS_CMAXO) + layer * D, layer >= P3I8_FROM, (const unsigned*)(ws + WS_CMAXI) + layer * NIN, layer >= P1I8_FROM, 1);
            p0_weights(F, W, (bf16*)(ws + WS_WIN), (signed char*)(ws + WS_WOUT), (signed char*)(ws + WS_WGU), (signed char*)(ws + WS_WD), (const unsigned*)(ws + WS_CMAX) + layer * NGU, (float*)(ws + WS_SB), (const unsigned*)(ws + WS_CMAXD) + layer * D, (const unsigned*)(ws + WS_CMAXO) + layer * D, layer >= P3I8_FROM, (const unsigned*)(ws + WS_CMAXI) + layer * NIN, layer >= P1I8_FROM, 2);
            if (layer == 0) p0_x(F, KA_IN(ka, 0), KA_IN(ka, 1), KA_OUT(ka), (bf16*)(ws + WS_XB), (float*)(ws + WS_RS));
            else if (layer >= P1I8_FROM) r_quant(F, (const float*)(ws + WS_SSP), (const bf16*)(ws + WS_XB), (signed char*)(ws + WS_XQ), (float*)(ws + WS_RS), (float*)(ws + WS_RS) + 4 * M);
            else reduce_rs(F, (const float*)(ws + WS_SSP), (float*)(ws + WS_RS));
            __syncthreads();
            seam(lds, pb + 0, wv);
        }
        if (in_range(pb + 1)) {
            kau64* ka = karg(); unsigned char* ws = KA_WS(ka);
            if (layer >= P1I8_FROM && P1I8_FROM > 0) {
            pg8::Gemm g{(const bf16*)(ws + WS_XQ), (const bf16*)(ws + WS_WIN), M, NIN, D / 2}; pg8::StaticOrder S; S.init(M, NIN, (int)gridDim.x, opaque_bx());
            pg8::EpiInProj E{(bf16*)(ws + WS_P), (const float*)(ws + WS_RS) + 4 * M, KA_IN(ka, 4) + layer * HD, KA_IN(ka, 5) + layer * HD, (LAS float*)(lds + QKTAB_OFF), (const float*)(ws + WS_SB) + NGU + 2 * D};
            pg8::gemm_phase<pg8::EpiInProj, pg8::StaticOrder, PG8_ALIGN, PG8_SP2, true>(lds + RING_OFF, g, S, E, wv);
            } else {
            pg8::Gemm g{(const bf16*)(ws + WS_XB), (const bf16*)(ws + WS_WIN), M, NIN, D}; pg8::StaticOrder S; S.init(M, NIN, (int)gridDim.x, opaque_bx());
            pg8::EpiInProj E{(bf16*)(ws + WS_P), (const float*)(ws + WS_RS), KA_IN(ka, 4) + layer * HD, KA_IN(ka, 5) + layer * HD, (LAS float*)(lds + QKTAB_OFF), nullptr};
            for (int rep = 0; rep < DUPN(8); ++rep) pg8::gemm_phase<pg8::EpiInProj, pg8::StaticOrder, PG8_ALIGN, PG8_SP2>(lds + RING_OFF, g, S, E, wv);
            }
            { Frame F = make_frame(lds, wv); const LayerW W = make_lw(ka, layer);
              p0_weights(F, W, (bf16*)(ws + WS_WIN), (signed char*)(ws + WS_WOUT), (signed char*)(ws + WS_WGU), (signed char*)(ws + WS_WD), (const unsigned*)(ws + WS_CMAX) + layer * NGU, (float*)(ws + WS_SB), (const unsigned*)(ws + WS_CMAXD) + layer * D, (const unsigned*)(ws + WS_CMAXO) + layer * D, layer >= P3I8_FROM, (const unsigned*)(ws + WS_CMAXI) + layer * NIN, layer >= P1I8_FROM, 3);
              __syncthreads(); }
            seam(lds, pb + 1, wv);
        }
        if (in_range(pb + 2)) {
            kau64* ka = karg(); unsigned char* ws = KA_WS(ka); Frame F = make_frame(lds, wv);
            for (int rep = 0; rep < DUPN(64); ++rep) att::attention(lds, (const bf16*)(ws + WS_P), (signed char*)(ws + WS_Y), KA_IN(ka, 6) + (size_t)layer * NH * 15 * 31, KA_IN(ka, 8) + layer * AW, KA_IN(ka, 4) + layer * HD, KA_IN(ka, 5) + layer * HD, layer >= P3I8_FROM, F.vcu, wv);
            for (int rep = 0; rep < DUPN(128); ++rep) p2_conv(F, (const bf16*)(ws + WS_P), (signed char*)(ws + WS_Y), KA_IN(ka, 7) + (size_t)layer * 3 * AW, KA_IN(ka, 9) + layer * AW, layer >= P3I8_FROM);
            for (int rep = 0; rep < DUPN(2) - 1; ++rep) {
            att::attention(lds, (const bf16*)(ws + WS_P), (signed char*)(ws + WS_Y), KA_IN(ka, 6) + (size_t)layer * NH * 15 * 31, KA_IN(ka, 8) + layer * AW, KA_IN(ka, 4) + layer * HD, KA_IN(ka, 5) + layer * HD, layer >= P3I8_FROM, F.vcu, wv);
            p2_conv(F, (const bf16*)(ws + WS_P), (signed char*)(ws + WS_Y), KA_IN(ka, 7) + (size_t)layer * 3 * AW, KA_IN(ka, 9) + layer * AW, layer >= P3I8_FROM);
            __syncthreads(); }
            __syncthreads();
            seam(lds, pb + 2, wv);
        }
        if (in_range(pb + 3)) {
            kau64* ka = karg(); unsigned char* ws = KA_WS(ka);
            if (layer >= P3I8_FROM) {
            pg8::Gemm g{(const bf16*)(ws + WS_Y), (const bf16*)(ws + WS_WOUT), M, D, D / 2}; pg8::StaticOrder S; S.init(M, D, (int)gridDim.x, opaque_bx());
            pg8::EpiResidI8 E{nullptr, (bf16*)(ws + WS_XB), nullptr, nullptr, (const float*)(ws + WS_SB) + NGU + D, YS};
            pg8::gemm_phase<pg8::EpiResidI8, pg8::StaticOrder, PG8_ALIGN, PG8_SP2, true>(lds + RING_OFF, g, S, E, wv);
            } else {
            pg8::Gemm g{(const bf16*)(ws + WS_Y), (const bf16*)(ws + WS_WOUT), M, D, D}; pg8::StaticOrder S; S.init(M, D, (int)gridDim.x, opaque_bx());
            pg8::EpiResid E{nullptr, (bf16*)(ws + WS_XB), nullptr};
            pg8::gemm_phase<pg8::EpiResid, pg8::StaticOrder, PG8_ALIGN, PG8_SP2>(lds + RING_OFF, g, S, E, wv);
            }
            seam(lds, pb + 3, wv);
        }
        if (in_range(pb + 4)) {
            kau64* ka = karg(); unsigned char* ws = KA_WS(ka); Frame F = make_frame(lds, wv);
            for (int rep = 0; rep < DUPN(4); ++rep) r_quant(F, (const float*)(ws + WS_SSP), (const bf16*)(ws + WS_XB), (signed char*)(ws + WS_XQ), (float*)(ws + WS_RS) + M, (float*)(ws + WS_RS) + 2 * M);
            __syncthreads();
            seam(lds, pb + 4, wv);
        }
        if (in_range(pb + 5)) {
            kau64* ka = karg(); unsigned char* ws = KA_WS(ka);
            pg8::Gemm g{(const bf16*)(ws + WS_XQ), (const bf16*)(ws + WS_WGU), M, NGU, D / 2};
            pg8::StealOrder S; S.init(M, NGU, (int)gridDim.x, opaque_bx(), P4_STATIC_STEPS, (unsigned*)(ws + WS_CTL) + CW_STEAL + 64 * layer, (volatile LAS int*)(lds + LDSCTL_OFF + 512));
            pg8::EpiGateUpI8 E{(bf16*)(ws + WS_H), (const float*)(ws + WS_RS) + 2 * M, (const float*)(ws + WS_SB)};
            pg8::gemm_phase<pg8::EpiGateUpI8, pg8::StealOrder, PG8_ALIGN, PG8_SP2, true>(lds + RING_OFF, g, S, E, wv);
            seam(lds, pb + 5, wv);
        }
        if (in_range(pb + 6)) {
            kau64* ka = karg(); unsigned char* ws = KA_WS(ka); Frame F = make_frame(lds, wv);
            h_quant(F, (const bf16*)(ws + WS_H), (signed char*)(ws + WS_H8), (float*)(ws + WS_RS) + 3 * M);
            __syncthreads();
            seam(lds, pb + 6, wv);
        }
        if (in_range(pb + 7)) {
            kau64* ka = karg(); unsigned char* ws = KA_WS(ka); const bool lastl = (layer == DEPTH - 1);
            pg8::Gemm g{(const bf16*)(ws + WS_H8), (const bf16*)(ws + WS_WD), M, D, FF / 2}; pg8::StaticOrder S; S.init(M, D, (int)gridDim.x, opaque_bx());
            pg8::EpiResidI8 E{lastl ? KA_OUT(ka) : nullptr, (bf16*)(ws + WS_XB), (layer + 1 < P1I8_FROM) ? (float*)(ws + WS_SSP) : nullptr, (const float*)(ws + WS_RS) + 3 * M, (const float*)(ws + WS_SB) + NGU, 0.f};
            pg8::gemm_phase<pg8::EpiResidI8, pg8::StaticOrder, PG8_ALIGN, PG8_SP2, true>(lds + RING_OFF, g, S, E, wv);
            if (!lastl) { Frame F = make_frame(lds, wv); const LayerW Wn = make_lw(ka, layer + 1);
                p0_weights(F, Wn, (bf16*)(ws + WS_WIN), (signed char*)(ws + WS_WOUT), (signed char*)(ws + WS_WGU), (signed char*)(ws + WS_WD), (const unsigned*)(ws + WS_CMAX) + (layer + 1) * NGU, (float*)(ws + WS_SB), (const unsigned*)(ws + WS_CMAXD) + (layer + 1) * D, (const unsigned*)(ws + WS_CMAXO) + (layer + 1) * D, layer + 1 >= P3I8_FROM, (const unsigned*)(ws + WS_CMAXI) + (layer + 1) * NIN, layer + 1 >= P1I8_FROM, 1);
                __syncthreads();
                seam(lds, pb + 7, wv); }
        }
    }
    { kau64* ka = karg();
      if (KA_HI(ka) == N_PHASES && xb_ld((unsigned*)(KA_WS(ka) + WS_CTL) + CW_BAR + XB_TMO) != 0u) {
          float* X = KA_OUT(ka); const float q = __builtin_nanf("");
          for (size_t i = (size_t)blockIdx.x * 512 + tid_of(wv); i < (size_t)M * D / 64; i += (size_t)gridDim.x * 512) X[i * 64] = q; } }
}

extern "C" void kernel_launch(void* const* d_in, const int* in_sizes, int n_in, void* d_out, int out_size, void* d_ws, size_t ws_size, hipStream_t stream) {
    static int grid = 0;
    if (grid == 0) {
        if (n_in != 15 || out_size != M * D || ws_size < WS_END) { fprintf(stderr, "kernel_launch: unexpected shapes (n_in %d, out %d, ws %zu)\n", n_in, out_size, ws_size); grid = -1; return; }
        int dev = 0, cus = 0, per_cu = 0;
        if (hipGetDevice(&dev) != hipSuccess || hipDeviceGetAttribute(&cus, hipDeviceAttributeMultiprocessorCount, dev) != hipSuccess) { grid = -1; return; }
        if (hipFuncSetAttribute((const void*)enc_fwd, hipFuncAttributeMaxDynamicSharedMemorySize, LDS_BYTES) != hipSuccess) { fprintf(stderr, "kernel_launch: hipFuncSetAttribute failed\n"); grid = -1; return; }
        if (hipOccupancyMaxActiveBlocksPerMultiprocessor(&per_cu, (const void*)enc_fwd, NWAVES * 64, LDS_BYTES) != hipSuccess || per_cu < 1) { fprintf(stderr, "kernel_launch: occupancy query says %d\n", per_cu); }
        (void)hipGetLastError();
        grid = cus;
    }
    if (grid < 0) return;
    if (hipMemsetAsync((char*)d_ws, 0, ZERO_BYTES, stream) != hipSuccess) { fprintf(stderr, "kernel_launch: memset failed\n"); return; }
    Args a{};
    for (int i = 0; i < 15; ++i) a.in[i] = (const float*)d_in[i];
    a.out = (float*)d_out; a.ws = (unsigned char*)d_ws;
    constexpr int NL = MK_N_LAUNCHES;
    for (int li = 0; li < NL; ++li) {
        a.ph_lo = (NL == 1) ? 0 : li; a.ph_hi = (NL == 1) ? N_PHASES : li + 1; a.li = (NL == 1) ? 0 : 0; a.pad = 0;
        hipLaunchKernelGGL(enc_fwd, dim3(grid), dim3(NWAVES * 64), LDS_BYTES, stream, a);
        const hipError_t le = hipPeekAtLastError();
        if (le != hipSuccess) { fprintf(stderr, "kernel_launch: launch failed: %s\n", hipGetErrorName(le)); break; }
    }
}
```

```cpp
#include <hip/hip_runtime.h>
#include <cstdio>
#include <cstdint>

__device__ __forceinline__ int tid_of(int wv) { asm volatile("" : "+s"(wv)); unsigned z = 0u; asm volatile("" : "+v"(z));
    return (wv << 6) | (int)__builtin_amdgcn_mbcnt_hi(~0u, __builtin_amdgcn_mbcnt_lo(~0u, z)); }
namespace pg8 {
#define PG8_LAS __attribute__((address_space(3)))
typedef unsigned short bf16_t;
typedef short bf16x8 __attribute__((ext_vector_type(8)));
typedef float f32x4 __attribute__((ext_vector_type(4)));
typedef unsigned u32x4 __attribute__((ext_vector_type(4)));
constexpr int BM = 256, BK = 64, HALF = 128, HTB = HALF * BK * 2  , STAGE_BYTES = 8 * HTB, NXCD = 8, WGM = 4;

__host__ __device__ __forceinline__ int lds_byte(int r, int c) { const int st = (r >> 4) * 2 + (c >> 5), rr = r & 15, cc = c & 31, ob = rr * 64 + cc * 2; return st * 1024 + (ob ^ (((ob >> 9) & 1) << 5)); }
__host__ __device__ __forceinline__ void stage_rc(int b, int& R, int& C) { const int st = b / 1024, sb = b % 1024, swz = sb ^ (((sb >> 9) & 1) << 5); R = (st >> 1) * 16 + swz / 64; C = (st & 1) * 32 + (swz % 64) / 2; }
__host__ __device__ __forceinline__ int perm32(int rho) { const int n = rho >> 4, i = rho & 15; return 8 * (i >> 2) + 4 * n + (i & 3); }

struct Unit { int pm, pn; };
struct Gemm { const bf16_t* A; const bf16_t* Bt; int M, N, K; };

struct StaticOrder {
    int nM, nN, nwg, G, c;
    __host__ __device__ void init(int M, int N, int G_, int c_) { nM = M / BM; nN = N / BM; nwg = nM * nN; G = G_; c = c_; }
    __host__ __device__ bool next(int i, Unit& u) const {
        const long L = (long)i * G + c; if (L >= nwg) return false;
        int wgid = (int)L; { const int q = nwg / NXCD, r = nwg % NXCD, xcd = wgid % NXCD, off = wgid / NXCD; wgid = (xcd < r ? xcd * (q + 1) : r * (q + 1) + (xcd - r) * q) + off; }
        const int nig = WGM * nN, gid = wgid / nig, fm = gid * WGM, gsz = (nM - fm) < WGM ? (nM - fm) : WGM;
        u.pm = fm + ((wgid % nig) % gsz); u.pn = (wgid % nig) / gsz; return true;
    }
    __device__ __forceinline__ void a_ready(const Unit&) const {}
    __device__ __forceinline__ void done(const Unit&) const {}
    __device__ __forceinline__ void tail(int, int, int) const {}
};

struct StealOrder {
    StaticOrder so; int S0, per; unsigned long long* ctr; PG8_LAS volatile int* slot;
    __device__ void init(int M, int N, int G_, int c_, int S0_, unsigned long long* ctr_, PG8_LAS volatile int* slot_) { so.init(M, N, G_, c_); S0 = S0_; ctr = ctr_; slot = slot_; per = (so.nwg - S0_ * G_) / NXCD; }
    __device__ __forceinline__ bool unit_of(int wgid, Unit& u) const {
        const int nig = WGM * so.nN, gid = wgid / nig, fm = gid * WGM, gsz = (so.nM - fm) < WGM ? (so.nM - fm) : WGM;
        u.pm = fm + ((wgid % nig) % gsz); u.pn = (wgid % nig) / gsz; return true; }
    __device__ __forceinline__ bool next(int i, Unit& u) const {
        if (i < S0) return so.next(i, u);
        const int w = __builtin_amdgcn_readfirstlane(slot[i & 1]); if (w < 0) return false;
        return unit_of(w, u);
    }
    __device__ __forceinline__ void a_ready(const Unit&) const {}
    __device__ __forceinline__ void done(const Unit&) const {}
    __device__ __forceinline__ void tail(int i, int wid, int lane) const {
        if (i + 2 < S0 || wid != 0) return;
        if (lane == 0) {
            const int q = so.nwg / NXCD, x = so.c % NXCD;
            unsigned mask = (i + 2 == S0) ? 0u : (unsigned)slot[2];
            int w = -1;
            for (int j = 0; j < NXCD && w < 0; ++j) {
                const int y = (x + j) % NXCD;
                if ((mask >> y) & 1u) continue;
                const unsigned long long old = __hip_atomic_fetch_add(ctr + 32 * y, j == 0 ? 1ull : (1ull << 32), __ATOMIC_RELAXED, __HIP_MEMORY_SCOPE_AGENT);
                const int f = (int)(unsigned)(old & 0xffffffffull), b = (int)(unsigned)(old >> 32);
                if (f + b < per) w = y * q + (q - per) + (j == 0 ? f : per - 1 - b);
                else mask |= 1u << y;
            }
            slot[2] = (int)mask; slot[i & 1] = w;
        }
        asm volatile("s_waitcnt lgkmcnt(0)" ::: "memory");
    }
};

__device__ __forceinline__ unsigned cvt_pk_bf16(float lo, float hi) { unsigned r; asm volatile("v_cvt_pk_bf16_f32 %0, %1, %2" : "=v"(r) : "v"(lo), "v"(hi)); return r; }

constexpr float RMS_EPS = 1e-6f;
__device__ __forceinline__ float rsvq(float x) { return rsqrtf(x); }

__device__ __forceinline__ void load_rows8(const float* p, int row0, float (&v)[2][4]) {
#pragma unroll
    for (int ai = 0; ai < 2; ++ai)
#pragma unroll
        for (int m = 0; m < 4; ++m) v[ai][m] = p[row0 + ai * HALF + m * 16];
    asm volatile("" : "+v"(v[0][0]), "+v"(v[0][1]), "+v"(v[0][2]), "+v"(v[0][3]), "+v"(v[1][0]), "+v"(v[1][1]), "+v"(v[1][2]), "+v"(v[1][3]));
}

typedef int i32x4 __attribute__((ext_vector_type(4)));
__device__ __forceinline__ f32x4 tof4(const f32x4& a) { return a; }
__device__ __forceinline__ f32x4 tof4(const i32x4& a) { return (f32x4){(float)a[0], (float)a[1], (float)a[2], (float)a[3]}; }
struct EpiInProj {
    static constexpr bool PERM = true, AFTER_DRAIN = false;
    bf16_t* P; const float* rs1; const float* qg; const float* kg; PG8_LAS float* tab; const float* sbc;
    template <class AccT>
    __device__ __forceinline__ void operator()(const AccT (&acc)[2][2][4][2], const Unit& u, int wr, int wc, int fr, int fq) const {
        const int row0 = u.pm * BM + wr * 64 + fr, col0 = u.pn * BM + wc * 32 + 8 * fq;
        const bool isq = u.pn < 4, isqk = u.pn < 8;
        f32x4 cs[2][2];
#pragma unroll
        for (int bj = 0; bj < 2; ++bj)
#pragma unroll
            for (int n = 0; n < 2; ++n) cs[bj][n] = sbc ? *(const f32x4*)(sbc + col0 + bj * HALF + 4 * n) : (f32x4){1.f, 1.f, 1.f, 1.f};
        if (isqk) {
            float cf[8];
            { const int d0 = wc * 32 + 8 * fq; const float* gp = isq ? qg : kg; const float sc = isq ? 0.08838834764831845f * 1.4426950408889634f : 1.0f;
#pragma unroll
              for (int j = 0; j < 8; ++j) cf[j] = gp[d0 + j] * sc; }
            float rsv[2][4]; load_rows8(rs1, row0, rsv);
#pragma unroll
            for (int ai = 0; ai < 2; ++ai)
#pragma unroll
                for (int m = 0; m < 4; ++m) {
                    const int rl = ai * HALF + wr * 64 + m * 16 + fr;
                    const float rs = rsv[ai][m];
#pragma unroll
                    for (int bj = 0; bj < 2; ++bj) {
                        const f32x4 v0 = tof4(acc[ai][bj][m][0]) * (cs[bj][0] * rs), v1 = tof4(acc[ai][bj][m][1]) * (cs[bj][1] * rs);
                        float s = (v0[0] * v0[0] + v0[1] * v0[1]) + (v0[2] * v0[2] + v0[3] * v0[3]) + (v1[0] * v1[0] + v1[1] * v1[1]) + (v1[2] * v1[2] + v1[3] * v1[3]);
                        s += __shfl_xor(s, 16); s += __shfl_xor(s, 32);
                        if (fq == 0) tab[rl * 8 + bj * 4 + wc] = s;
                    }
                }
            asm volatile("s_waitcnt lgkmcnt(0)" ::: "memory"); __builtin_amdgcn_s_barrier(); asm volatile("" ::: "memory");
#pragma unroll
            for (int ai = 0; ai < 2; ++ai)
#pragma unroll
                for (int m = 0; m < 4; ++m) {
                    const int rl = ai * HALF + wr * 64 + m * 16 + fr;
                    bf16_t* rowp = P + (size_t)(u.pm * BM + rl) * 5120 + col0;
#pragma unroll
                    for (int bj = 0; bj < 2; ++bj) {
                        const f32x4 t = *(const PG8_LAS f32x4*)(tab + rl * 8 + bj * 4);
                        const float rn = rsvq(((t[0] + t[1]) + (t[2] + t[3])) * (1.0f / 128.0f) + RMS_EPS) * rsv[ai][m];
                        const f32x4 v0 = tof4(acc[ai][bj][m][0]) * (cs[bj][0] * rn), v1 = tof4(acc[ai][bj][m][1]) * (cs[bj][1] * rn);
                        u32x4 w; w.x = cvt_pk_bf16(v0[0] * cf[0], v0[1] * cf[1]); w.y = cvt_pk_bf16(v0[2] * cf[2], v0[3] * cf[3]);
                        w.z = cvt_pk_bf16(v1[0] * cf[4], v1[1] * cf[5]); w.w = cvt_pk_bf16(v1[2] * cf[6], v1[3] * cf[7]);
                        *(u32x4*)(rowp + bj * HALF) = w;
                    }
                }
        } else if (u.pn >= 16) {
            float rsv[2][4]; load_rows8(rs1, row0, rsv);
            const f32x4 cp0 = cs[0][0] * cs[1][0], cp1 = cs[0][1] * cs[1][1];
            bf16_t* cup = P + 4096 + (u.pn - 16) * HALF + wc * 32 + 8 * fq;
#pragma unroll
            for (int ai = 0; ai < 2; ++ai)
#pragma unroll
                for (int m = 0; m < 4; ++m) {
                    const int r = row0 + ai * HALF + m * 16;
                    const float rs2 = rsv[ai][m] * rsv[ai][m];
                    const f32x4 v0 = tof4(acc[ai][0][m][0]) * tof4(acc[ai][1][m][0]) * (cp0 * rs2), v1 = tof4(acc[ai][0][m][1]) * tof4(acc[ai][1][m][1]) * (cp1 * rs2);
                    u32x4 w; w.x = cvt_pk_bf16(v0[0], v0[1]); w.y = cvt_pk_bf16(v0[2], v0[3]); w.z = cvt_pk_bf16(v1[0], v1[1]); w.w = cvt_pk_bf16(v1[2], v1[3]);
                    *(u32x4*)(cup + (size_t)r * 5120) = w;
                }
        } else {
            float rsv[2][4]; load_rows8(rs1, row0, rsv);
#pragma unroll
            for (int ai = 0; ai < 2; ++ai)
#pragma unroll
                for (int m = 0; m < 4; ++m) {
                    const int r = row0 + ai * HALF + m * 16;
                    const float rs = rsv[ai][m];
                    bf16_t* rowp = P + (size_t)r * 5120 + col0;
#pragma unroll
                    for (int bj = 0; bj < 2; ++bj) {
                        const f32x4 v0 = tof4(acc[ai][bj][m][0]) * (cs[bj][0] * rs), v1 = tof4(acc[ai][bj][m][1]) * (cs[bj][1] * rs);
                        u32x4 w; w.x = cvt_pk_bf16(v0[0], v0[1]); w.y = cvt_pk_bf16(v0[2], v0[3]); w.z = cvt_pk_bf16(v1[0], v1[1]); w.w = cvt_pk_bf16(v1[2], v1[3]);
                        *(u32x4*)(rowp + bj * HALF) = w;
                    }
                }
        }
    }
};

struct EpiResid {
    static constexpr bool PERM = true, AFTER_DRAIN = false;
    float* X; bf16_t* XB; float* ssn;
    __device__ __forceinline__ void operator()(const f32x4 (&acc)[2][2][4][2], const Unit& u, int wr, int wc, int fr, int fq) const {
        const int row0 = u.pm * BM + wr * 64 + fr, col0 = u.pn * BM + wc * 32 + 8 * fq;
#pragma unroll
        for (int ai = 0; ai < 2; ++ai) {
            u32x4 o[4][2];
#pragma unroll
            for (int m = 0; m < 4; ++m) { const bf16_t* xp = XB + (size_t)(row0 + ai * HALF + m * 16) * 2048 + col0;
#pragma unroll
                for (int bj = 0; bj < 2; ++bj) o[m][bj] = *(const u32x4*)(xp + bj * HALF); }
#pragma unroll
            for (int m = 0; m < 4; ++m) {
                const int r = row0 + ai * HALF + m * 16;
                float s = 0.f;
#pragma unroll
                for (int bj = 0; bj < 2; ++bj) {
                    const u32x4 w0 = o[m][bj];
                    f32x4 o0 = {__builtin_bit_cast(float, w0.x << 16), __builtin_bit_cast(float, w0.x & 0xffff0000u), __builtin_bit_cast(float, w0.y << 16), __builtin_bit_cast(float, w0.y & 0xffff0000u)};
                    f32x4 o1 = {__builtin_bit_cast(float, w0.z << 16), __builtin_bit_cast(float, w0.z & 0xffff0000u), __builtin_bit_cast(float, w0.w << 16), __builtin_bit_cast(float, w0.w & 0xffff0000u)};
                    o0 = o0 + acc[ai][bj][m][0]; o1 = o1 + acc[ai][bj][m][1];
                    if (X) { float* xp = X + (size_t)r * 2048 + col0 + bj * HALF; *(f32x4*)xp = o0; *(f32x4*)(xp + 4) = o1; }
                    else {
                        if (ssn) s += (o0[0] * o0[0] + o0[1] * o0[1]) + (o0[2] * o0[2] + o0[3] * o0[3]) + (o1[0] * o1[0] + o1[1] * o1[1]) + (o1[2] * o1[2] + o1[3] * o1[3]);
                        u32x4 w; w.x = cvt_pk_bf16(o0[0], o0[1]); w.y = cvt_pk_bf16(o0[2], o0[3]); w.z = cvt_pk_bf16(o1[0], o1[1]); w.w = cvt_pk_bf16(o1[2], o1[3]);
                        *(u32x4*)(XB + (size_t)r * 2048 + col0 + bj * HALF) = w; }
                }
                if (!X && ssn) { s += __shfl_xor(s, 16); s += __shfl_xor(s, 32); if (fq == 0) ssn[(size_t)(u.pn * 4 + wc) * 49152 + r] = s; }
            }
        }
    }
};

typedef int i32x4 __attribute__((ext_vector_type(4)));
struct EpiResidI8 {
    static constexpr bool PERM = true, AFTER_DRAIN = false;
    float* X; bf16_t* XB; float* ssn; const float* hs; const float* sbd; float hconst;
    __device__ __forceinline__ void operator()(const i32x4 (&acc)[2][2][4][2], const Unit& u, int wr, int wc, int fr, int fq) const {
        const int row0 = u.pm * BM + wr * 64 + fr, col0 = u.pn * BM + wc * 32 + 8 * fq;
        f32x4 cs[2][2];
#pragma unroll
        for (int bj = 0; bj < 2; ++bj) { cs[bj][0] = *(const f32x4*)(sbd + col0 + bj * HALF); cs[bj][1] = *(const f32x4*)(sbd + col0 + bj * HALF + 4); }
        float rsv[2][4];
        if (hs) load_rows8(hs, row0, rsv); else {
#pragma unroll
            for (int i = 0; i < 8; ++i) rsv[i >> 2][i & 3] = hconst; }
#pragma unroll
        for (int ai = 0; ai < 2; ++ai) {
            u32x4 o[4][2];
#pragma unroll
            for (int m = 0; m < 4; ++m) { const bf16_t* xp = XB + (size_t)(row0 + ai * HALF + m * 16) * 2048 + col0;
#pragma unroll
                for (int bj = 0; bj < 2; ++bj) o[m][bj] = *(const u32x4*)(xp + bj * HALF); }
#pragma unroll
            for (int m = 0; m < 4; ++m) {
                const int r = row0 + ai * HALF + m * 16;
                const float rs = rsv[ai][m];
                float s = 0.f;
#pragma unroll
                for (int bj = 0; bj < 2; ++bj) {
                    const u32x4 w0 = o[m][bj];
                    f32x4 o0 = {__builtin_bit_cast(float, w0.x << 16), __builtin_bit_cast(float, w0.x & 0xffff0000u), __builtin_bit_cast(float, w0.y << 16), __builtin_bit_cast(float, w0.y & 0xffff0000u)};
                    f32x4 o1 = {__builtin_bit_cast(float, w0.z << 16), __builtin_bit_cast(float, w0.z & 0xffff0000u), __builtin_bit_cast(float, w0.w << 16), __builtin_bit_cast(float, w0.w & 0xffff0000u)};
                    const i32x4 a0 = acc[ai][bj][m][0], a1 = acc[ai][bj][m][1];
                    o0 = o0 + (f32x4){(float)a0[0], (float)a0[1], (float)a0[2], (float)a0[3]} * (cs[bj][0] * rs);
                    o1 = o1 + (f32x4){(float)a1[0], (float)a1[1], (float)a1[2], (float)a1[3]} * (cs[bj][1] * rs);
                    if (X) { float* xp = X + (size_t)r * 2048 + col0 + bj * HALF; *(f32x4*)xp = o0; *(f32x4*)(xp + 4) = o1; }
                    else {
                        if (ssn) s += (o0[0] * o0[0] + o0[1] * o0[1]) + (o0[2] * o0[2] + o0[3] * o0[3]) + (o1[0] * o1[0] + o1[1] * o1[1]) + (o1[2] * o1[2] + o1[3] * o1[3]);
                        u32x4 w; w.x = cvt_pk_bf16(o0[0], o0[1]); w.y = cvt_pk_bf16(o0[2], o0[3]); w.z = cvt_pk_bf16(o1[0], o1[1]); w.w = cvt_pk_bf16(o1[2], o1[3]);
                        *(u32x4*)(XB + (size_t)r * 2048 + col0 + bj * HALF) = w; }
                }
                if (!X && ssn) { s += __shfl_xor(s, 16); s += __shfl_xor(s, 32); if (fq == 0) ssn[(size_t)(u.pn * 4 + wc) * 49152 + r] = s; }
            }
        }
    }
};

struct EpiGateUp {
    static constexpr bool PERM = true, AFTER_DRAIN = false;
    bf16_t* H; const float* ss;
    __device__ __forceinline__ void operator()(const f32x4 (&acc)[2][2][4][2], const Unit& u, int wr, int wc, int fr, int fq) const {
        const int row0 = u.pm * BM + wr * 64 + fr, col0 = u.pn * HALF + wc * 32 + 8 * fq;
        float rsv[2][4]; load_rows8(ss, row0, rsv);
#pragma unroll
        for (int ai = 0; ai < 2; ++ai)
#pragma unroll
            for (int m = 0; m < 4; ++m) {
                const int r = row0 + ai * HALF + m * 16;
                const float rs = rsv[ai][m];
                float hv[8];
#pragma unroll
                for (int n = 0; n < 2; ++n)
#pragma unroll
                    for (int j = 0; j < 4; ++j) {
                        const float g = acc[ai][0][m][n][j] * rs, up = acc[ai][1][m][n][j] * rs;
                        const float sg = g * __builtin_amdgcn_rcpf(1.0f + __builtin_amdgcn_exp2f(-1.4426950408889634f * g));
                        hv[n * 4 + j] = sg * up;
                    }
                u32x4 w; w.x = cvt_pk_bf16(hv[0], hv[1]); w.y = cvt_pk_bf16(hv[2], hv[3]); w.z = cvt_pk_bf16(hv[4], hv[5]); w.w = cvt_pk_bf16(hv[6], hv[7]);
                *(u32x4*)(H + (size_t)r * 5632 + col0) = w;
            }
    }
};

typedef int i32x4 __attribute__((ext_vector_type(4)));
__device__ __forceinline__ f32x4 mma_bf(bf16x8 a, bf16x8 b, f32x4 c) { return __builtin_amdgcn_mfma_f32_16x16x32_bf16(a, b, c, 0, 0, 0); }
__device__ __forceinline__ i32x4 mma_i8(bf16x8 a, bf16x8 b, i32x4 c) { return __builtin_amdgcn_mfma_i32_16x16x64_i8(__builtin_bit_cast(i32x4, a), __builtin_bit_cast(i32x4, b), c, 0, 0, 0); }
struct EpiGateUpI8 {
    static constexpr bool PERM = true, AFTER_DRAIN = false;
    bf16_t* H; const float* rowf; const float* sb;
    __device__ __forceinline__ void operator()(const i32x4 (&acc)[2][2][4][2], const Unit& u, int wr, int wc, int fr, int fq) const {
        const int row0 = u.pm * BM + wr * 64 + fr, col0 = u.pn * HALF + wc * 32 + 8 * fq;
        float sg[8], su[8];
        { const float* sp = sb + u.pn * BM + wc * 32 + 8 * fq; const f32x4 a = *(const f32x4*)sp, b = *(const f32x4*)(sp + 4), c = *(const f32x4*)(sp + HALF), d = *(const f32x4*)(sp + HALF + 4);
          sg[0] = a[0]; sg[1] = a[1]; sg[2] = a[2]; sg[3] = a[3]; sg[4] = b[0]; sg[5] = b[1]; sg[6] = b[2]; sg[7] = b[3];
          su[0] = c[0]; su[1] = c[1]; su[2] = c[2]; su[3] = c[3]; su[4] = d[0]; su[5] = d[1]; su[6] = d[2]; su[7] = d[3]; }
#pragma unroll
        for (int e = 0; e < 8; ++e) { sg[e] *= 1.4426950408889634f; su[e] *= 0.6931471805599453f; }
        float rsv[2][4]; load_rows8(rowf, row0, rsv);
#pragma unroll
        for (int ai = 0; ai < 2; ++ai)
#pragma unroll
            for (int m = 0; m < 4; ++m) {
                const int r = row0 + ai * HALF + m * 16;
                const float rs = rsv[ai][m];
                float g2[8], gu[8], hv[8];
#pragma unroll
                for (int e = 0; e < 8; ++e) { g2[e] = (float)acc[ai][0][m][e >> 2][e & 3] * (rs * sg[e]); gu[e] = g2[e] * ((float)acc[ai][1][m][e >> 2][e & 3] * (rs * su[e])); }
#pragma unroll
                for (int e = 0; e < 8; ++e) g2[e] = __builtin_amdgcn_exp2f(-g2[e]);
#pragma unroll
                for (int e = 0; e < 8; ++e) g2[e] = __builtin_amdgcn_rcpf(1.0f + g2[e]);
#pragma unroll
                for (int e = 0; e < 8; ++e) hv[e] = gu[e] * g2[e];
                u32x4 w; w.x = cvt_pk_bf16(hv[0], hv[1]); w.y = cvt_pk_bf16(hv[2], hv[3]); w.z = cvt_pk_bf16(hv[4], hv[5]); w.w = cvt_pk_bf16(hv[6], hv[7]);
                *(u32x4*)(H + (size_t)r * 5632 + col0) = w;
            }
    }
};

template <bool I8> struct AccSel { typedef f32x4 type; };
template <> struct AccSel<true> { typedef i32x4 type; };
template <class Epi, class Sched, bool ALIGN_EPI = false, bool SP2 = false, bool I8 = false>
__device__ __forceinline__ void gemm_phase(PG8_LAS unsigned char* lds, const Gemm g, const Sched& S, const Epi& E, const int wv) {
    int tid_ = tid_of(wv); asm volatile("" : "+v"(tid_));
    const int tid = tid_, wid = __builtin_amdgcn_readfirstlane(tid >> 6), lane = tid & 63, wr = wid >> 2, wc = wid & 3, fr = lane & 15, fq = lane >> 4;
    const int K = g.K, nt = K / BK;
    unsigned voffA[2], voffB[2];
#pragma unroll
    for (int i = 0; i < 2; ++i) { int R, C; stage_rc(tid * 16 + i * 8192, R, C); const int Rb = Epi::PERM ? ((R & ~31) + perm32(R & 31)) : R;
        voffA[i] = (unsigned)(R * K + C) * 2u; voffB[i] = (unsigned)(Rb * K + C) * 2u; }
    const size_t kstep = (size_t)(BK * 2);
    const size_t hstep = (size_t)HALF * K * 2;
    const size_t tstep = 2 * hstep;
    const unsigned ldsw = (unsigned)wid * 1024u;
    const int aoff = lds_byte(wr * 64 + fr, fq * 8), boff = lds_byte(wc * 32 + fr, fq * 8);
#define PG8_SA(b, h) (((b) * 2 + (h)) * HTB)
#define PG8_SB(b, h) ((4 + (b) * 2 + (h)) * HTB)
#define PG8_STAGE(bufoff, gbase, voff) do { _Pragma("unroll") for (int _i = 0; _i < 2; ++_i) \
        __builtin_amdgcn_global_load_lds((const unsigned*)((const char*)(gbase) + (voff)[_i]), (PG8_LAS unsigned*)(lds + (bufoff) + ldsw + _i * 8192), 16, 0, 0); } while (0)
#define PG8_LDA(dst, b, h) do { _Pragma("unroll") for (int m = 0; m < 4; ++m) _Pragma("unroll") for (int k = 0; k < 2; ++k) dst[m][k] = *(const PG8_LAS bf16x8*)(lds + PG8_SA(b, h) + aoff + m * 2048 + k * 1024); } while (0)
#define PG8_LDB(dst, b, h) do { _Pragma("unroll") for (int n = 0; n < 2; ++n) _Pragma("unroll") for (int k = 0; k < 2; ++k) dst[n][k] = *(const PG8_LAS bf16x8*)(lds + PG8_SB(b, h) + boff + n * 2048 + k * 1024); } while (0)
#define PG8_MMA(ai, bj, At, Bt) do { __builtin_amdgcn_s_setprio(1); _Pragma("unroll") for (int m = 0; m < 4; ++m) _Pragma("unroll") for (int n = 0; n < 2; ++n) _Pragma("unroll") for (int k = 0; k < 2; ++k) \
        { if constexpr (I8) acc[ai][bj][m][n] = mma_i8(Bt[n][k], At[m][k], acc[ai][bj][m][n]); else acc[ai][bj][m][n] = mma_bf(Bt[n][k], At[m][k], acc[ai][bj][m][n]); } __builtin_amdgcn_s_setprio(0); } while (0)
#define PG8_WAIT_V(n) asm volatile("s_waitcnt vmcnt(" #n ")" ::: "memory")
#define PG8_WAIT_L(n) asm volatile("s_waitcnt lgkmcnt(" #n ")" ::: "memory")
#define PG8_BAR __builtin_amdgcn_s_barrier()
#define PG8_SCHED __builtin_amdgcn_sched_barrier(0)
    Unit cur, nxt; int ui = 0;
    if (!S.next(0, cur)) return;
    typedef typename AccSel<I8>::type acc_t;
    acc_t acc[2][2][4][2];
#pragma unroll
    for (int a = 0; a < 2; ++a)
#pragma unroll
        for (int b = 0; b < 2; ++b)
#pragma unroll
            for (int m = 0; m < 4; ++m)
#pragma unroll
                for (int n = 0; n < 2; ++n) acc[a][b][m][n] = (acc_t){0, 0, 0, 0};
    bf16x8 At[4][2], B0[2][2], B1[2][2];
    const char* cA = (const char*)g.A + (size_t)cur.pm * tstep; const char* cB = (const char*)g.Bt + (size_t)cur.pn * tstep;
    S.a_ready(cur);
    if constexpr (SP2) {
        PG8_STAGE(PG8_SB(0, 0), cB, voffB); PG8_STAGE(PG8_SB(0, 1), cB + hstep, voffB); PG8_STAGE(PG8_SA(0, 0), cA, voffA); PG8_STAGE(PG8_SA(0, 1), cA + hstep, voffA);
        if (wr == 1) PG8_BAR;
        PG8_WAIT_V(2); PG8_BAR;
        PG8_STAGE(PG8_SB(1, 0), cB + kstep, voffB); PG8_STAGE(PG8_SA(1, 0), cA + kstep, voffA); PG8_STAGE(PG8_SB(1, 1), cB + hstep + kstep, voffB);
        PG8_WAIT_V(6); PG8_BAR;
    } else {
        PG8_STAGE(PG8_SB(0, 0), cB, voffB); PG8_STAGE(PG8_SA(0, 0), cA, voffA); PG8_STAGE(PG8_SB(0, 1), cB + hstep, voffB); PG8_STAGE(PG8_SA(0, 1), cA + hstep, voffA);
        if (wr == 1) PG8_BAR;
        PG8_WAIT_V(4); PG8_BAR;
        PG8_STAGE(PG8_SB(1, 0), cB + kstep, voffB); PG8_STAGE(PG8_SA(1, 0), cA + kstep, voffA); PG8_STAGE(PG8_SB(1, 1), cB + hstep + kstep, voffB);
        PG8_WAIT_V(6); PG8_BAR;
    }
    for (;;) {
        const bool has_next = S.next(ui + 1, nxt);
        const char* nA = has_next ? (const char*)g.A + (size_t)nxt.pm * tstep : cA; const char* nB = has_next ? (const char*)g.Bt + (size_t)nxt.pn * tstep : cB;
        for (int t = 0; t < nt; t += 2) {
            const bool last = (t == nt - 2);
            const char* a1 = cA + (size_t)(t + 1) * kstep;
            const char* a2 = last ? nA : cA + (size_t)(t + 2) * kstep; const char* b2 = last ? nB : cB + (size_t)(t + 2) * kstep;
            const char* a3 = a2 + kstep; const char* b3 = b2 + kstep;
            if (last && has_next) S.a_ready(nxt);
            if constexpr (SP2) {
            PG8_LDB(B0, 0, 0); PG8_LDB(B1, 0, 1); PG8_SCHED; PG8_LDA(At, 0, 0); PG8_STAGE(PG8_SA(1, 1), a1 + hstep, voffA);
            PG8_WAIT_V(8); PG8_WAIT_L(0); PG8_BAR; PG8_MMA(0, 0, At, B0); PG8_MMA(0, 1, At, B1); PG8_BAR; PG8_SCHED;
            PG8_LDA(At, 0, 1); PG8_STAGE(PG8_SB(0, 0), b2, voffB); PG8_STAGE(PG8_SB(0, 1), b2 + hstep, voffB); PG8_STAGE(PG8_SA(0, 0), a2, voffA);
            PG8_WAIT_V(8); PG8_WAIT_L(0); PG8_BAR; PG8_MMA(1, 0, At, B0); PG8_MMA(1, 1, At, B1); PG8_BAR; PG8_SCHED;
            PG8_LDB(B0, 1, 0); PG8_LDB(B1, 1, 1); PG8_SCHED; PG8_LDA(At, 1, 0); PG8_STAGE(PG8_SA(0, 1), a2 + hstep, voffA);
            PG8_WAIT_V(8); PG8_WAIT_L(0); PG8_BAR; PG8_MMA(0, 0, At, B0); PG8_MMA(0, 1, At, B1); PG8_BAR; PG8_SCHED;
            PG8_LDA(At, 1, 1); PG8_STAGE(PG8_SB(1, 0), b3, voffB); PG8_STAGE(PG8_SB(1, 1), b3 + hstep, voffB); PG8_STAGE(PG8_SA(1, 0), a3, voffA);
            PG8_WAIT_V(8); PG8_WAIT_L(0); PG8_BAR; PG8_MMA(1, 0, At, B0); PG8_MMA(1, 1, At, B1); PG8_BAR; PG8_SCHED;
            } else {
            PG8_LDB(B0, 0, 0); PG8_SCHED; PG8_LDA(At, 0, 0); PG8_STAGE(PG8_SA(1, 1), a1 + hstep, voffA);
            PG8_WAIT_L(8); PG8_BAR; PG8_WAIT_L(0); PG8_MMA(0, 0, At, B0); PG8_BAR; PG8_SCHED;
            PG8_LDB(B1, 0, 1); PG8_STAGE(PG8_SB(0, 0), b2, voffB);
            PG8_BAR; PG8_WAIT_L(0); PG8_MMA(0, 1, At, B1); PG8_BAR;
            PG8_LDA(At, 0, 1); PG8_STAGE(PG8_SA(0, 0), a2, voffA);
            PG8_BAR; PG8_WAIT_L(0); PG8_MMA(1, 0, At, B0); PG8_BAR; PG8_SCHED;
            PG8_STAGE(PG8_SB(0, 1), b2 + hstep, voffB);
            PG8_WAIT_V(6); PG8_BAR; PG8_MMA(1, 1, At, B1); PG8_BAR;
            PG8_LDB(B0, 1, 0); PG8_SCHED; PG8_LDA(At, 1, 0); PG8_STAGE(PG8_SA(0, 1), a2 + hstep, voffA);
            PG8_WAIT_L(8); PG8_BAR; PG8_WAIT_L(0); PG8_MMA(0, 0, At, B0); PG8_BAR; PG8_SCHED;
            PG8_LDB(B1, 1, 1); PG8_STAGE(PG8_SB(1, 0), b3, voffB);
            PG8_BAR; PG8_WAIT_L(0); PG8_MMA(0, 1, At, B1); PG8_BAR;
            PG8_LDA(At, 1, 1); PG8_STAGE(PG8_SA(1, 0), a3, voffA);
            PG8_BAR; PG8_WAIT_L(0); PG8_MMA(1, 0, At, B0); PG8_BAR; PG8_SCHED;
            PG8_STAGE(PG8_SB(1, 1), b3 + hstep, voffB);
            PG8_WAIT_V(6); PG8_BAR; PG8_MMA(1, 1, At, B1); PG8_BAR;
            }
        }
        S.tail(ui, wid, lane);
        if constexpr (ALIGN_EPI) { if (wr == 0) PG8_BAR; }
        if constexpr (!Epi::AFTER_DRAIN) { E(acc, cur, wr, wc, fr, fq); S.done(cur); }
        if (!has_next) break;
#pragma unroll
        for (int a = 0; a < 2; ++a)
#pragma unroll
            for (int b = 0; b < 2; ++b)
#pragma unroll
                for (int m = 0; m < 4; ++m)
#pragma unroll
                    for (int n = 0; n < 2; ++n) acc[a][b][m][n] = (acc_t){0, 0, 0, 0};
        cur = nxt; cA = nA; cB = nB; ++ui;
        if constexpr (ALIGN_EPI) { if (wr == 1) PG8_BAR; }
    }
    PG8_WAIT_V(0);
    if constexpr (!ALIGN_EPI) { if (wr == 0) PG8_BAR; }
    PG8_BAR;
#undef PG8_SA
#undef PG8_SB
#undef PG8_STAGE
#undef PG8_LDA
#undef PG8_LDB
#undef PG8_MMA
#undef PG8_WAIT_V
#undef PG8_WAIT_L
#undef PG8_BAR
#undef PG8_SCHED
}
}

#ifndef PG8_SP2
#define PG8_SP2 true
#endif
#ifndef PG8_ALIGN
#define PG8_ALIGN true
#endif

constexpr int NWAVES = 8;
constexpr int PW = 5120;
__device__ __forceinline__ int in_dst_col(int n) { if (n < 4096) return n; const int isu = n >= 5120 ? 1 : 0, c = n - 4096 - isu * 1024; return 4096 + (c >> 7) * 256 + isu * 128 + (c & 127); }
constexpr int D = 2048, NIN = 6144, FF = 5632, NGU = 2 * FF, DEPTH = 4, HD = 128, NH = 8, AW = 1024;
constexpr int M_P = 2 * 16384, M_S = 2 * 8192, M = M_P + M_S;
constexpr int GRID_W = 64;
constexpr float YC = 22.627416997969522f, YQ = 127.0f / YC, YS = YC / 127.0f;
#ifndef DUP_MASK
#define DUP_MASK 0
#endif
#define DUPN(bit) ((DUP_MASK & (bit)) ? 2 : 1)
#ifndef P3I8_FROM
#define P3I8_FROM 1
#endif
#ifndef P1I8_FROM
#define P1I8_FROM 1
#endif
#ifndef MK_N_LAUNCHES
#define MK_N_LAUNCHES 1
#endif

constexpr size_t MiB = 1u << 20;
constexpr size_t WS_CTL = 0, CTL_BYTES = 1 * MiB;
constexpr size_t ZERO_BYTES = 1 * MiB;
constexpr size_t WS_CMAX = 256 * 1024;
constexpr size_t WS_CMAXD = 448 * 1024;
constexpr size_t WS_H8 = 864 * MiB;
constexpr size_t WS_CMAXO = 480 * 1024;
constexpr size_t WS_CMAXI = 512 * 1024;
constexpr size_t WS_RS = 1 * MiB;
constexpr size_t WS_SSP = 2 * MiB;
constexpr size_t WS_SB = 8 * MiB;
constexpr size_t WS_WIN = 20 * MiB, WS_WOUT = 44 * MiB, WS_WGU = 52 * MiB, WS_WD = 74 * MiB;
constexpr size_t WS_XB = 96 * MiB;
constexpr size_t WS_P = 288 * MiB;
constexpr size_t WS_Y = 864 * MiB;
constexpr size_t WS_XQ = 1056 * MiB;
constexpr size_t WS_H = 288 * MiB;
constexpr size_t WS_END = 1152 * MiB;
static_assert(WS_CMAX + (size_t)DEPTH * NGU * 4 <= ZERO_BYTES && WS_RS + (size_t)5 * M * 4 <= WS_SSP && WS_CMAXD + (size_t)DEPTH * D * 4 <= ZERO_BYTES && WS_H8 + (size_t)M * FF <= WS_END && WS_SB + (size_t)(NGU + 2 * D + NIN) * 4 <= WS_WIN && WS_CMAXI + (size_t)DEPTH * NIN * 4 <= ZERO_BYTES && WS_CMAXO + (size_t)DEPTH * D * 4 <= ZERO_BYTES && WS_SSP + (size_t)32 * M * 4 <= WS_SB && WS_SB + (size_t)NGU * 4 <= WS_WIN, "ws map 1");
static_assert(WS_WIN + (size_t)NIN * D * 2 <= WS_WOUT && WS_WOUT + (size_t)D * D * 2 <= WS_WGU && WS_WGU + (size_t)NGU * D <= WS_WD && WS_WD + (size_t)D * FF * 2 <= WS_XB, "ws map 2");
static_assert(WS_XB + (size_t)M * D * 2 <= WS_P && WS_P + (size_t)M * NIN * 2 <= WS_Y && WS_H + (size_t)M * FF * 2 <= WS_Y && WS_Y + (size_t)M * D * 2 <= WS_XQ && WS_XQ + (size_t)M * D <= WS_END, "ws map 3");
constexpr int CW_BAR = 4096;
constexpr int CW_STEAL = 32768;
constexpr int P4_STATIC_STEPS = 30;

constexpr int RING_OFF = 0, RING_BYTES = 131072;
constexpr int LDSCTL_OFF = RING_BYTES, MISC_OFF = LDSCTL_OFF + 320;
constexpr int QKTAB_OFF = RING_BYTES + 1024;
constexpr int LDS_BYTES = 147456;

#define GAS __attribute__((address_space(1)))
#define LAS __attribute__((address_space(3)))
typedef unsigned short bf16;
typedef unsigned v4u __attribute__((ext_vector_type(4)));
typedef unsigned v2u __attribute__((ext_vector_type(2)));
typedef float f32x4 __attribute__((ext_vector_type(4)));
typedef GAS unsigned gu32;
#define RLX_AGENT __ATOMIC_RELAXED, __HIP_MEMORY_SCOPE_AGENT
#define LDS_WAIT() asm volatile("s_waitcnt lgkmcnt(0)" ::: "memory")
#define VM_WAIT() asm volatile("s_waitcnt vmcnt(0)" ::: "memory")
__device__ __forceinline__ unsigned f2bf(float f) { unsigned u = __builtin_bit_cast(unsigned, f); return (u + 0x7fffu + ((u >> 16) & 1u)) >> 16; }
__device__ __forceinline__ unsigned pk2(float lo, float hi) { return f2bf(lo) | (f2bf(hi) << 16); }
__device__ __forceinline__ float bflo(unsigned u) { return __builtin_bit_cast(float, u << 16); }
__device__ __forceinline__ float bfhi(unsigned u) { return __builtin_bit_cast(float, u & 0xffff0000u); }

#define XB_TMO      128
#define XB_XCNT(j)  (256  + 64 * (j))
#define XB_XSUB(j)  (1280 + 64 * (j))
#define XB_XGEN(j)  (2304 + 64 * (j))
#define XB_TOP      3328
#define XB_TOPGEN   3392
#define XCD_BAR_WORDS 3456
#define XB_SPIN_CAP (1u << 23)

__device__ __forceinline__ unsigned xb_ld(unsigned* p)              { return __hip_atomic_load(p, __ATOMIC_RELAXED, __HIP_MEMORY_SCOPE_AGENT); }
__device__ __forceinline__ unsigned xb_add(unsigned* p, unsigned v) { return __hip_atomic_fetch_add(p, v, __ATOMIC_RELAXED, __HIP_MEMORY_SCOPE_AGENT); }
__device__ __forceinline__ unsigned xb_xcc_id() { return (unsigned)__builtin_amdgcn_s_getreg((3 << 11) | 20) & 0xFu; }
#define XB_SPIN(cond, bar) do { unsigned _sp = 0; while (cond) { __builtin_amdgcn_s_sleep(1); \
    if ((++_sp & 255u) == 0u) { if (xb_ld(&(bar)[XB_TMO])) break; if (_sp > XB_SPIN_CAP) { atomicAdd(&(bar)[XB_TMO], 1u); break; } } } } while (0)

struct XcdBarrier { unsigned* bar; unsigned x; volatile LAS unsigned* st; };

__device__ __forceinline__ XcdBarrier xcd_barrier_post(unsigned* bar, volatile LAS unsigned* st, const int wv) {
    XcdBarrier b; b.bar = bar; b.x = xb_xcc_id(); b.st = st;
    if (tid_of(wv) == 0) (void)xb_add(&bar[XB_XCNT(b.x)], 1u);
    return b;
}
__device__ __forceinline__ void xcd_barrier_complete(unsigned* bar, unsigned x, unsigned& nloc, unsigned& nx) {
    const unsigned G = gridDim.x * gridDim.y * gridDim.z;
    unsigned sum, cnt, mine, sp = 0u;
    for (;;) {
        sum = 0u; cnt = 0u; mine = 0u;
#pragma unroll
        for (unsigned j = 0; j < 16; ++j) { const unsigned c = xb_ld(&bar[XB_XCNT(j)]); sum += c; cnt += (c > 0u) ? 1u : 0u; mine = (j == x) ? c : mine; }
        if (sum == G) break;
        __builtin_amdgcn_s_sleep(1);
        if ((++sp & 255u) == 0u) { if (xb_ld(&bar[XB_TMO])) break; if (sp > XB_SPIN_CAP) { atomicAdd(&bar[XB_TMO], 1u); break; } }
    }
    nloc = mine > 0u ? mine : 1u; nx = cnt > 0u ? cnt : 1u;
}
__device__ __forceinline__ void xcd_barrier(const XcdBarrier& b, const int wv) {
    asm volatile("s_waitcnt vmcnt(0)" ::: "memory");
    __syncthreads();
    if (tid_of(wv) == 0) {
        unsigned* bar = b.bar;
        __builtin_amdgcn_s_waitcnt(0);
        unsigned nloc = b.st[0], nx = b.st[1];
        if (nloc == 0u) { xcd_barrier_complete(bar, b.x, nloc, nx); b.st[0] = nloc; b.st[1] = nx; }
        const unsigned old = xb_add(&bar[XB_XSUB(b.x)], 1u);
        const unsigned gen = old / nloc;
        if (old + 1u == (gen + 1u) * nloc) {
            __builtin_amdgcn_fence(__ATOMIC_RELEASE, "agent");
            asm volatile("s_waitcnt vmcnt(0)" ::: "memory");
            const unsigned og = xb_add(&bar[XB_TOP], 1u);
            const unsigned tg = og / nx;
            if (og + 1u == (tg + 1u) * nx) xb_add(&bar[XB_TOPGEN], 1u);
            else XB_SPIN(xb_ld(&bar[XB_TOPGEN]) == tg, bar);
            __builtin_amdgcn_fence(__ATOMIC_ACQUIRE, "agent");
            xb_add(&bar[XB_XGEN(b.x)], 1u);
            asm volatile("s_waitcnt vmcnt(0)" ::: "memory");
        } else {
            XB_SPIN(xb_ld(&bar[XB_XGEN(b.x)]) == gen, bar);
            __builtin_amdgcn_fence(__ATOMIC_ACQUIRE, "agent");
            asm volatile("s_waitcnt vmcnt(0)" ::: "memory");
        }
    }
    __syncthreads();
}

struct Frame {
    LAS unsigned char* lds;
    volatile LAS unsigned* MISC;
    gu32* ctl;
    int tid, lane, wave;
    int vcu, G;
};

__device__ __forceinline__ float wave_sum(float v) {
#pragma unroll
    for (int o = 1; o < 64; o <<= 1) v += __shfl_xor(v, o);
    return v;
}
__device__ __forceinline__ float wave_max(float v) {
#pragma unroll
    for (int o = 1; o < 64; o <<= 1) v = fmaxf(v, __shfl_xor(v, o));
    return v;
}

__device__ __forceinline__ void p0_transpose_item(const float* W, int K, int N, bf16* WT, int k0, int n0, int out_row0, const float* gain, LAS float* scr, int lane) {
    { float tv[32];
#pragma unroll
      for (int i = 0; i < 32; ++i) { const int kk = 2 * i + (lane >> 5); tv[i] = W[(size_t)(k0 + kk) * N + n0 + (lane & 31)]; }
#pragma unroll
      for (int i = 0; i < 32; ++i) { const int kk = 2 * i + (lane >> 5); float v = tv[i]; if (gain) v *= gain[k0 + kk]; scr[kk * 33 + (lane & 31)] = v; } }
    LDS_WAIT(); asm volatile("" ::: "memory");
    const int c = lane & 7;
#pragma unroll
    for (int j = 0; j < 4; ++j) { const int n = (lane >> 3) + 8 * j; const LAS float* s = scr + (8 * c) * 33 + n;
        v4u o; o.x = pk2(s[0 * 33], s[1 * 33]); o.y = pk2(s[2 * 33], s[3 * 33]); o.z = pk2(s[4 * 33], s[5 * 33]); o.w = pk2(s[6 * 33], s[7 * 33]);
        *(GAS v4u*)(WT + (size_t)(out_row0 + n) * K + k0 + 8 * c) = o; }
    LDS_WAIT(); asm volatile("" ::: "memory");
}

template <int N> __device__ __forceinline__ void wht_regs(float (&f)[N]) {
#pragma unroll
    for (int s = 1; s < N; s <<= 1)
#pragma unroll
        for (int i = 0; i < N; ++i) if ((i & s) == 0) { const float a = f[i], b = f[i | s]; f[i] = a + b; f[i | s] = a - b; }
}
__device__ __forceinline__ float dpp_xor1(float v) { return __builtin_bit_cast(float, __builtin_amdgcn_update_dpp(0, __builtin_bit_cast(int, v), 0xB1, 0xF, 0xF, true)); }
__device__ __forceinline__ float dpp_xor2(float v) { return __builtin_bit_cast(float, __builtin_amdgcn_update_dpp(0, __builtin_bit_cast(int, v), 0x4E, 0xF, 0xF, true)); }

__device__ __forceinline__ unsigned q8x4(float a, float b, float c, float d, float inv) {
    const unsigned ua = __builtin_bit_cast(unsigned, fmaf(a, inv, 12582912.0f)), ub = __builtin_bit_cast(unsigned, fmaf(b, inv, 12582912.0f));
    const unsigned uc = __builtin_bit_cast(unsigned, fmaf(c, inv, 12582912.0f)), ud = __builtin_bit_cast(unsigned, fmaf(d, inv, 12582912.0f));
    return __builtin_amdgcn_perm(__builtin_amdgcn_perm(ud, uc, 0x0c0c0400u), __builtin_amdgcn_perm(ub, ua, 0x0c0c0400u), 0x05040100u);
}
__device__ __forceinline__ unsigned q8x4c(float a, float b, float c, float d, float scale) {
    const float lo = 12582912.0f - 127.0f, hi = 12582912.0f + 127.0f;
    const unsigned ua = __builtin_bit_cast(unsigned, fminf(fmaxf(fmaf(a, scale, 12582912.0f), lo), hi)), ub = __builtin_bit_cast(unsigned, fminf(fmaxf(fmaf(b, scale, 12582912.0f), lo), hi));
    const unsigned uc = __builtin_bit_cast(unsigned, fminf(fmaxf(fmaf(c, scale, 12582912.0f), lo), hi)), ud = __builtin_bit_cast(unsigned, fminf(fmaxf(fmaf(d, scale, 12582912.0f), lo), hi));
    return __builtin_amdgcn_perm(__builtin_amdgcn_perm(ud, uc, 0x0c0c0400u), __builtin_amdgcn_perm(ub, ua, 0x0c0c0400u), 0x05040100u);
}
template <bool ROT> __device__ __forceinline__ void p0_q8_item(const float* W, int K, int N, signed char* W8, int k0, int n0, int out_row0, const float* gain, const unsigned* cmax, LAS float* scr, int lane) {
    { float tv[32];
#pragma unroll
      for (int i = 0; i < 32; ++i) { const int kk = 2 * i + (lane >> 5); tv[i] = W[(size_t)(k0 + kk) * N + n0 + (lane & 31)]; }
#pragma unroll
      for (int i = 0; i < 32; ++i) { const int kk = 2 * i + (lane >> 5); float v = tv[i]; if (gain) v *= gain[k0 + kk]; scr[kk * 33 + (lane & 31)] = v; } }
    LDS_WAIT(); asm volatile("" ::: "memory");
    const int n = lane >> 1, half = lane & 1;
    const float cm = __builtin_bit_cast(float, cmax[out_row0 + n]), inv = cm > 0.f ? 127.0f / cm : 0.f;
    const LAS float* s = scr + (32 * half) * 33 + n;
    float vv[32];
#pragma unroll
    for (int j = 0; j < 32; ++j) vv[j] = s[j * 33];
    if (ROT) { wht_regs<32>(vv);
#pragma unroll
        for (int j = 0; j < 32; ++j) vv[j] *= (1.0f / 32.0f); }
    unsigned w[8];
#pragma unroll
    for (int j = 0; j < 8; ++j) w[j] = q8x4(vv[4 * j], vv[4 * j + 1], vv[4 * j + 2], vv[4 * j + 3], inv);
    GAS v4u* dst = (GAS v4u*)(W8 + (size_t)(out_row0 + n) * K + k0 + 32 * half);
    dst[0] = (v4u){w[0], w[1], w[2], w[3]}; dst[1] = (v4u){w[4], w[5], w[6], w[7]};
    LDS_WAIT(); asm volatile("" ::: "memory");
}

__device__ __forceinline__ void pa_colmax(Frame& F, const float* w_gate, const float* w_up, const float* norm2, unsigned* cmax, const float* w_down, unsigned* cmaxd, const float* w_out, const float* aog, const float* cog, unsigned* cmaxo, const float* w_in, const float* norm1, unsigned* cmaxi) {
    const int gw = F.vcu * NWAVES + F.wave, NGW = F.G * NWAVES;
    constexpr int NB = FF / 64, PER_MAT = (D / 64) * NB, NITEMS = DEPTH * 2 * PER_MAT;
    for (int it = gw; it < NITEMS; it += NGW) {
        const int layer = it / (2 * PER_MAT), r0 = it - layer * 2 * PER_MAT, isup = r0 / PER_MAT, r = r0 - isup * PER_MAT, kb = r / NB, nb = r - kb * NB;
        const float* Wp = (isup ? w_up : w_gate) + (size_t)layer * D * FF + (size_t)(64 * kb) * FF + 64 * nb + F.lane;
        const float* gp = norm2 + layer * D + 64 * kb;
        float mx = 0.f;
#pragma unroll 32
        for (int k = 0; k < 64; ++k) mx = fmaxf(mx, fabsf(Wp[(size_t)k * FF] * gp[k]));
        const int n = 64 * nb + F.lane, row = n + (n / 128) * 128 + isup * 128;
        atomicMax(cmax + layer * NGU + row, __builtin_bit_cast(unsigned, mx));
    }
    constexpr int NBD = D / 64, PER_D = (FF / 64) * NBD, NITEMS_D = DEPTH * PER_D;
    for (int it = gw; it < NITEMS_D; it += NGW) {
        const int layer = it / PER_D, r = it - layer * PER_D, kb = r / NBD, nb = r - kb * NBD;
        const float* Wp = w_down + (size_t)layer * FF * D + (size_t)(64 * kb) * D + 64 * nb + F.lane;
        float mx = 0.f;
#pragma unroll
        for (int hb = 0; hb < 2; ++hb) { float vv[32];
#pragma unroll
            for (int k = 0; k < 32; ++k) vv[k] = Wp[(size_t)(32 * hb + k) * D];
            wht_regs<32>(vv);
#pragma unroll
            for (int k = 0; k < 32; ++k) mx = fmaxf(mx, fabsf(vv[k] * (1.0f / 32.0f))); }
        atomicMax(cmaxd + layer * D + 64 * nb + F.lane, __builtin_bit_cast(unsigned, mx));
    }
    constexpr int PER_O = (D / 64) * NBD, NITEMS_O = DEPTH * PER_O;
    for (int it = gw; it < NITEMS_O; it += NGW) {
        const int layer = it / PER_O, r = it - layer * PER_O, kb = r / NBD, nb = r - kb * NBD;
        const float* Wp = w_out + (size_t)layer * D * D + (size_t)(64 * kb) * D + 64 * nb + F.lane;
        const float* gp = (64 * kb < AW) ? aog + layer * AW + 64 * kb : cog + layer * AW + 64 * kb - AW;
        float mx = 0.f;
#pragma unroll
        for (int hb = 0; hb < 2; ++hb) { float vv[32];
#pragma unroll
            for (int k = 0; k < 32; ++k) vv[k] = Wp[(size_t)(32 * hb + k) * D] * gp[32 * hb + k];
            wht_regs<32>(vv);
#pragma unroll
            for (int k = 0; k < 32; ++k) mx = fmaxf(mx, fabsf(vv[k] * (1.0f / 32.0f))); }
        atomicMax(cmaxo + layer * D + 64 * nb + F.lane, __builtin_bit_cast(unsigned, mx));
    }
    constexpr int NBI = NIN / 64, PER_I = (D / 64) * NBI;
    for (int it = gw; it < (DEPTH - P1I8_FROM) * PER_I; it += NGW) {
        const int layer = P1I8_FROM + it / PER_I, r = it % PER_I, kb = r / NBI, nb = r - kb * NBI;
        const float* Wp = w_in + (size_t)layer * D * NIN + (size_t)(64 * kb) * NIN + 64 * nb + F.lane;
        const float* gp = norm1 + layer * D + 64 * kb;
        float mx = 0.f;
#pragma unroll 32
        for (int k = 0; k < 64; ++k) mx = fmaxf(mx, fabsf(Wp[(size_t)k * NIN] * gp[k]));
        atomicMax(cmaxi + layer * NIN + in_dst_col(64 * nb + F.lane), __builtin_bit_cast(unsigned, mx));
    }
}

struct LayerW { const float *norm1, *w_in, *qg, *kg, *rpb, *conv_w, *aog, *cog, *w_out, *norm2, *w_gate, *w_up, *w_down; };

__device__ __forceinline__ void p0_weights(Frame& F, const LayerW& W, bf16* Win_t, signed char* Wout8, signed char* Wgu8, signed char* Wd8, const unsigned* cmax, float* sb, const unsigned* cmaxd, const unsigned* cmaxo, const bool yi8, const unsigned* cmaxi, const bool xi8, const int part) {
    LAS float* scr = (LAS float*)(F.lds + RING_OFF + F.wave * 16384);
    const int gw = F.vcu * NWAVES + F.wave, NGW = F.G * NWAVES;
    constexpr int I_IN = (D / 64) * (NIN / 32), I_OUT = (D / 64) * (D / 32), I_G = (D / 64) * (FF / 32), I_D = (FF / 64) * (D / 32);
    constexpr int NITEMS = I_IN + I_OUT + 2 * I_G + I_D, NA = I_IN + I_OUT + 2 * I_G;
    const int it_lo = (part == 2) ? NA : 0, it_hi = (part == 1) ? NA : NITEMS;
    for (int it = it_lo + gw; it < it_hi; it += NGW) {
        int r = it;
        if (r < I_IN) { const int nblk = NIN / 32, kb = r / nblk, nb = r % nblk; if (xi8) p0_q8_item<false>(W.w_in, D, NIN, (signed char*)Win_t, 64 * kb, 32 * nb, in_dst_col(32 * nb), W.norm1, cmaxi, scr, F.lane); else p0_transpose_item(W.w_in, D, NIN, Win_t, 64 * kb, 32 * nb, in_dst_col(32 * nb), W.norm1, scr, F.lane); continue; } r -= I_IN;
        if (r < I_OUT) { const int nblk = D / 32, kb = r / nblk, nb = r % nblk; if (yi8) p0_q8_item<true>(W.w_out, D, D, Wout8, 64 * kb, 32 * nb, 32 * nb, (64 * kb < AW) ? W.aog : W.cog - AW, cmaxo, scr, F.lane); else p0_transpose_item(W.w_out, D, D, (bf16*)Wout8, 64 * kb, 32 * nb, 32 * nb, nullptr, scr, F.lane); continue; } r -= I_OUT;
        if (r < I_G) { const int nblk = FF / 32, kb = r / nblk, nb = r % nblk, n0 = 32 * nb; p0_q8_item<false>(W.w_gate, D, FF, Wgu8, 64 * kb, n0, n0 + (n0 / 128) * 128, W.norm2, cmax, scr, F.lane); continue; } r -= I_G;
        if (r < I_G) { const int nblk = FF / 32, kb = r / nblk, nb = r % nblk, n0 = 32 * nb; p0_q8_item<false>(W.w_up, D, FF, Wgu8, 64 * kb, n0, n0 + (n0 / 128) * 128 + 128, W.norm2, cmax, scr, F.lane); continue; } r -= I_G;
        { const int nblk = D / 32, kb = r / nblk, nb = r % nblk; p0_q8_item<true>(W.w_down, FF, D, Wd8, 64 * kb, 32 * nb, 32 * nb, nullptr, cmaxd, scr, F.lane); }
    }
    if (part == 1) return;
    if (xi8) for (int i = F.vcu * 512 + F.tid; i < NIN; i += F.G * 512) sb[NGU + 2 * D + i] = __builtin_bit_cast(float, cmaxi[i]) * (1.0f / 127.0f);
    for (int i = F.vcu * 512 + F.tid; i < NGU + 2 * D; i += F.G * 512) sb[i] = __builtin_bit_cast(float, i < NGU ? cmax[i] : (i < NGU + D ? cmaxd[i - NGU] : cmaxo[i - NGU - D])) * (1.0f / 127.0f);
}

__device__ __forceinline__ void p0_x(Frame& F, const float* xp, const float* xs, float* out, bf16* XB, float* ss0) {
    const int gw = F.vcu * NWAVES + F.wave, NGW = F.G * NWAVES;
    for (int m0 = gw; m0 < M; m0 += 2 * NGW) {
        f32x4 v[2][8];
#pragma unroll
        for (int rr = 0; rr < 2; ++rr) { const int m = m0 + rr * NGW;
            const float* src = (m < M_P) ? xp + (size_t)m * D : xs + (size_t)(m - M_P) * D;
            const GAS f32x4* xr = (const GAS f32x4*)src + F.lane;
#pragma unroll
            for (int j = 0; j < 8; ++j) v[rr][j] = xr[64 * j]; }
#pragma unroll
        for (int rr = 0; rr < 2; ++rr) { const int m = m0 + rr * NGW;
            GAS v2u* brow = (GAS v2u*)(XB + (size_t)m * D) + F.lane;
            float s = 0.f;
#pragma unroll
            for (int j = 0; j < 8; ++j) { const f32x4 w = v[rr][j]; s += (w.x * w.x + w.y * w.y) + (w.z * w.z + w.w * w.w);
                v2u b; b.x = pk2(w.x, w.y); b.y = pk2(w.z, w.w); brow[64 * j] = b; }
            s = wave_sum(s);
            if (F.lane == 0) ss0[m] = rsqrtf(s * (1.0f / 2048.0f) + 1e-6f); }
    }
}

__device__ __forceinline__ void reduce_rs(Frame& F, const float* SSP, float* rs) {
    for (int r = F.vcu * 512 + F.tid; r < M; r += F.G * 512) {
        float s = 0.f;
#pragma unroll 8
        for (int j = 0; j < 32; ++j) s += SSP[(size_t)j * M + r];
        rs[r] = rsqrtf(s * (1.0f / 2048.0f) + 1e-6f);
    }
}

__device__ __forceinline__ void r_quant(Frame& F, const float* SSP, const bf16* XB, signed char* XQ, float* rs2, float* rowf) {
    const int gw = F.vcu * NWAVES + F.wave, NGW = F.G * NWAVES, lane = F.lane;
    constexpr int RB = 4;
    for (int m0 = gw; m0 < M; m0 += RB * NGW) {
        v4u v[RB][4];
#pragma unroll
        for (int rr = 0; rr < RB; ++rr) { const int m = m0 + rr * NGW; const bool ok = m < M; const int mc = ok ? m : gw;
            const GAS v4u* xr = (const GAS v4u*)(XB + (size_t)mc * D) + lane;
#pragma unroll
            for (int j = 0; j < 4; ++j) v[rr][j] = xr[64 * j]; }
#pragma unroll
        for (int rr = 0; rr < RB; ++rr) { const int m = m0 + rr * NGW; if (m >= M) break;
            float f[4][8]; float mx = 0.f, sq = 0.f;
#pragma unroll
            for (int j = 0; j < 4; ++j) { f[j][0] = bflo(v[rr][j].x); f[j][1] = bfhi(v[rr][j].x); f[j][2] = bflo(v[rr][j].y); f[j][3] = bfhi(v[rr][j].y); f[j][4] = bflo(v[rr][j].z); f[j][5] = bfhi(v[rr][j].z); f[j][6] = bflo(v[rr][j].w); f[j][7] = bfhi(v[rr][j].w);
#pragma unroll
                for (int e = 0; e < 8; ++e) { mx = fmaxf(mx, fabsf(f[j][e])); sq += f[j][e] * f[j][e]; } }
            mx = wave_max(mx);
            const float rstd = rsqrtf(wave_sum(sq) * (1.0f / 2048.0f) + 1e-6f);
            const float inv = mx > 0.f ? 127.0f / mx : 0.f;
            GAS v2u* qr = (GAS v2u*)(XQ + (size_t)m * D) + lane;
#pragma unroll
            for (int j = 0; j < 4; ++j) qr[64 * j] = (v2u){q8x4(f[j][0], f[j][1], f[j][2], f[j][3], inv), q8x4(f[j][4], f[j][5], f[j][6], f[j][7], inv)};
            if (lane == 0) { rs2[m] = rstd; rowf[m] = mx * (1.0f / 127.0f) * rstd; }
        }
    }
}

__device__ __forceinline__ void h_quant_row(const v4u (&v)[11], const int m, const int lane, const float s1, const float s2, signed char* H8, float* hs) {
    float f[11][8]; float mx = 0.f;
#pragma unroll
    for (int j = 0; j < 11; ++j) {
        f[j][0] = bflo(v[j].x); f[j][1] = bfhi(v[j].x); f[j][2] = bflo(v[j].y); f[j][3] = bfhi(v[j].y); f[j][4] = bflo(v[j].z); f[j][5] = bfhi(v[j].z); f[j][6] = bflo(v[j].w); f[j][7] = bfhi(v[j].w);
        wht_regs<8>(f[j]);
#pragma unroll
        for (int e = 0; e < 8; ++e) { const float p = dpp_xor1(f[j][e]); f[j][e] = fmaf(f[j][e], s1, p); }
#pragma unroll
        for (int e = 0; e < 8; ++e) { const float p = dpp_xor2(f[j][e]); f[j][e] = fmaf(f[j][e], s2, p); mx = fmaxf(mx, fabsf(f[j][e])); }
    }
    mx = wave_max(mx);
    const float inv = mx > 0.f ? 127.0f / mx : 0.f;
    GAS v2u* qr = (GAS v2u*)(H8 + (size_t)m * FF) + lane;
#pragma unroll
    for (int j = 0; j < 11; ++j) qr[64 * j] = (v2u){q8x4(f[j][0], f[j][1], f[j][2], f[j][3], inv), q8x4(f[j][4], f[j][5], f[j][6], f[j][7], inv)};
    if (lane == 0) hs[m] = mx * (1.0f / 127.0f);
}
__device__ __forceinline__ void h_quant(Frame& F, const bf16* H, signed char* H8, float* hs) {
    const int gw = F.vcu * NWAVES + F.wave, NGW = F.G * NWAVES, lane = F.lane;
    const float s1 = (lane & 1) ? -1.0f : 1.0f, s2 = (lane & 2) ? -1.0f : 1.0f;
#define HQ_LOAD(v, m_) do { const GAS v4u* hr_ = (const GAS v4u*)(H + (size_t)(m_) * FF) + lane; _Pragma("unroll") for (int j = 0; j < 11; ++j) v[j] = hr_[64 * j]; } while (0)
    v4u va[11], vb[11];
    const int NK = M / NGW;
#define HQ_ROW(k_) ([&](const int kk) { const int i_ = (kk & 3) * NGW + gw, g_ = 5 - (kk >> 2); return 6144 * (i_ >> 10) + 1024 * g_ + (i_ & 1023); }(k_))
    const bool remap = (NGW == 2048);
    HQ_LOAD(va, remap ? HQ_ROW(0) : gw);
    for (int k = 0; k < NK; k += 2) {
        const int m0 = remap ? HQ_ROW(k) : gw + k * NGW, m1 = remap ? HQ_ROW(k + 1) : gw + (k + 1) * NGW, m2 = (k + 2 < NK) ? (remap ? HQ_ROW(k + 2) : gw + (k + 2) * NGW) : m0;
        HQ_LOAD(vb, m1);
        h_quant_row(va, m0, lane, s1, s2, H8, hs);
        if (k + 2 < NK) HQ_LOAD(va, m2);
        h_quant_row(vb, m1, lane, s1, s2, H8, hs);
    }
#undef HQ_ROW
#undef HQ_LOAD
}

__device__ __forceinline__ void seq_of(int t, int& base, int& L) {
    if (t < M_P) { L = 16384; base = (t >> 14) << 14; } else { L = 8192; base = M_P + (((t - M_P) >> 13) << 13); }
}

namespace att {
typedef short bf16x8 __attribute__((ext_vector_type(8)));
typedef short s16x4 __attribute__((ext_vector_type(4)));
typedef short v4i16_t __attribute__((ext_vector_type(4)));
constexpr int PAIRB = 32768, NPAIR = 4, RPB_OFF = QKTAB_OFF, RPB_ROWS = 17, GAIN_OFF = RPB_OFF + RPB_ROWS * 128, RED_OFF = GAIN_OFF + 512, UPW = 6;
constexpr float LOG2E = 1.4426950408889634f;
struct UnitGeo { int base, rows, r0, j0, nr; };
__device__ __forceinline__ int clampi(int x, int lo, int hi) { return x < lo ? lo : (x > hi ? hi : x); }
__device__ __forceinline__ UnitGeo unit_geo(int vcu, int ui) {
    UnitGeo g; const int gp = ui * 32 + (vcu >> 3); int rq;
    if (gp < 128) { rq = gp & 63; g.rows = 256; g.base = (gp >> 6) * 16384; }
    else { const int q = gp - 128; rq = q & 31; g.rows = 128; g.base = M_P + (q >> 5) * 8192; }
    g.r0 = 4 * rq;
    const int a = clampi(g.r0 - 4, 0, g.rows - 8), b = clampi(g.r0 - 1, 0, g.rows - 8);
    g.j0 = a; g.nr = b + 8 - a;
    return g;
}
__device__ __forceinline__ void glds16(const void* gsrc, unsigned lds_dst) { unsigned keep;
    asm volatile("s_mov_b32 %0, m0\n\ts_mov_b32 m0, %2\n\ts_nop 0\n\tglobal_load_lds_dwordx4 %1, off\n\ts_mov_b32 m0, %0" : "=&s"(keep) : "v"(gsrc), "s"(lds_dst) : "memory"); }
__device__ __forceinline__ s16x4 vtr(unsigned addr) { return __builtin_bit_cast(s16x4, __builtin_amdgcn_ds_read_tr16_b64_v4i16((LAS v4i16_t*)(size_t)addr)); }

__device__ __forceinline__ void attention(LAS unsigned char* lds, const bf16* P, signed char* Y, const float* rpb, const float* aog, const float* qg, const float* kg, const bool yi8, int vcu, const int wv) {
    int tid_ = tid_of(wv); asm volatile("" : "+v"(tid_));
    const int tid = tid_, wave = __builtin_amdgcn_readfirstlane(tid >> 6), lane = tid & 63, q = lane & 15, g = lane >> 4;
    const int n = wave & 3, grp = wave >> 2, h = vcu & 7;
    const unsigned ldsb = (unsigned)(size_t)lds;
    LAS float* red = (LAS float*)(lds + RED_OFF);
    { float mb = 0.f, mq = 0.f, mk = 0.f;
      for (int i = tid; i < 15 * 31; i += 512) mb = fmaxf(mb, fabsf(rpb[h * 15 * 31 + i]));
      if (tid < HD) { mq = fabsf(qg[tid]); mk = fabsf(kg[tid]); }
#pragma unroll
      for (int o = 1; o < 64; o <<= 1) { mb = fmaxf(mb, __shfl_xor(mb, o)); mq = fmaxf(mq, __shfl_xor(mq, o)); mk = fmaxf(mk, __shfl_xor(mk, o)); }
      if (lane == 0) { red[wave * 4 + 0] = mb; red[wave * 4 + 1] = mq; red[wave * 4 + 2] = mk; } }
    __syncthreads();
    float shift;
    { float mb = 0.f, mq = 0.f, mk = 0.f;
#pragma unroll
      for (int w = 0; w < 8; ++w) { mb = fmaxf(mb, red[w * 4 + 0]); mq = fmaxf(mq, red[w * 4 + 1]); mk = fmaxf(mk, red[w * 4 + 2]); }
      shift = fminf(64.0f, mq * mk * (11.313708498984761f * LOG2E * 1.01f) + mb * LOG2E + 0.25f); }
    LAS float* rt = (LAS float*)(lds + RPB_OFF);
    for (int i = tid; i < RPB_ROWS * 32; i += 512) { const int rr = i >> 5, cc = i & 31; float v = -1e30f;
        if (rr >= 1 && rr <= 15 && cc < 31) v = rpb[(h * 15 + rr - 1) * 31 + cc] * LOG2E - shift; rt[i] = v; }
    if (!yi8 && tid < HD) ((LAS float*)(lds + GAIN_OFF))[tid] = aog[h * HD + tid];
    const int bs = (n == 0) ? 0 : (n == 1 ? 8 : (n == 2 ? 24 : 32));
    const int c = 16 * n + q, cs = clampi(c - 8, 0, 48);
    const int kpg = (g == 0) ? 0 : (g == 1 ? 2 : (g == 2 ? 3 : 1)), qa = q >> 2, pq = (qa == 0) ? 0 : (qa == 1 ? 2 : (qa == 2 ? 3 : 1));
    unsigned ci[2][4];
#pragma unroll
    for (int hf = 0; hf < 2; ++hf)
#pragma unroll
        for (int rg = 0; rg < 4; ++rg) { const int kc = bs + 16 * hf + 4 * kpg + rg; const bool cvv = (kc >= cs) && (kc < cs + 16); ci[hf][rg] = ldsb + RPB_OFF + (unsigned)((cvv ? clampi(kc - c + 15, 0, 30) : 31) * 4); }
    unsigned koff[2], kx[2];
#pragma unroll
    for (int hf = 0; hf < 2; ++hf) { const unsigned rowk = bs + 16 * hf + 4 * pq + (q & 3); koff[hf] = 256u * rowk + 16u * (g ^ ((rowk >> 2) & 3u)); kx[hf] = rowk & 3u; }
    const unsigned qp = q >> 2, pp = q & 3;
    unsigned voff[2], vfx[2];
#pragma unroll
    for (int t = 0; t < 2; ++t) { const unsigned rowv = bs + 16 * t + 4 * kpg + qp, f = ((rowv & 3u) << 2) | ((rowv >> 2) & 3u);
        voff[t] = 16384u + 256u * rowv + 8u * (pp & 1u) + 16u * ((pp >> 1) ^ (f & 1u)); vfx[t] = f & 14u; }
    unsigned goff[2];
#pragma unroll
    for (int i = 0; i < 2; ++i) { const unsigned pos = i * 512 + tid, row = pos >> 4, pch = pos & 15u, ch = pch ^ (((row & 3u) << 2) | ((row >> 2) & 3u)); goff[i] = row * (unsigned)(PW * 2) + ch * 16u; }
    __syncthreads();
    int pu = 0, pt = 0, issued = 0, consumed = 0, islot = 0, cslot = 0; UnitGeo pg = unit_geo(vcu, 0);
#define ATT_ISSUE() do { if (pu < UPW) { \
        const char* gp_ = (const char*)P + ((size_t)(pg.base + (pg.j0 + pt) * 64) * PW + AW + h * HD) * 2; const unsigned ld_ = ldsb + (unsigned)(islot * PAIRB + wave * 1024); \
        glds16(gp_ + goff[0], ld_); glds16(gp_ + goff[1], ld_ + 8192u); glds16(gp_ + 2 * AW + goff[0], ld_ + 16384u); glds16(gp_ + 2 * AW + goff[1], ld_ + 24576u); \
        ++issued; islot = (islot + 1) & (NPAIR - 1); if (++pt == pg.nr) { pt = 0; if (++pu < UPW) pg = unit_geo(vcu, pu); } } } while (0)
#define ATT_SYNC(qadd_) do { const int nv_ = 4 * (issued - consumed - 1) + (qadd_); \
        if (nv_ >= 16) asm volatile("s_waitcnt vmcnt(16)" ::: "memory"); else if (nv_ == 12) asm volatile("s_waitcnt vmcnt(12)" ::: "memory"); else if (nv_ == 8) asm volatile("s_waitcnt vmcnt(8)" ::: "memory"); \
        else if (nv_ == 4) asm volatile("s_waitcnt vmcnt(4)" ::: "memory"); else asm volatile("s_waitcnt vmcnt(0)" ::: "memory"); \
        asm volatile("s_waitcnt lgkmcnt(0)" ::: "memory"); __builtin_amdgcn_s_barrier(); asm volatile("" ::: "memory"); \
        slotb = ldsb + (unsigned)(cslot * PAIRB); cslot = (cslot + 1) & (NPAIR - 1); ++consumed; } while (0)
    ATT_ISSUE(); ATT_ISSUE(); ATT_ISSUE();
    unsigned slotb = 0;
    bf16x8 qn[2][4];
    { const UnitGeo G0 = unit_geo(vcu, 0);
#pragma unroll
      for (int rr = 0; rr < 2; ++rr) { const bf16* qptr = P + (size_t)(G0.base + (G0.r0 + 2 * grp + rr) * 64 + c) * PW + h * HD + 8 * g;
#pragma unroll
          for (int ks = 0; ks < 4; ++ks) qn[rr][ks] = *(const GAS bf16x8*)(qptr + 32 * ks); }
      asm volatile("" : "+v"(qn[0][0]), "+v"(qn[0][1]), "+v"(qn[0][2]), "+v"(qn[0][3]), "+v"(qn[1][0]), "+v"(qn[1][1]), "+v"(qn[1][2]), "+v"(qn[1][3])); }
    for (int ui = 0; ui < UPW; ++ui) {
        const UnitGeo G = unit_geo(vcu, ui);
        const int ra = G.r0 + 2 * grp;
        int offd[2], tq[2]; unsigned tb[2];
#pragma unroll
        for (int rr = 0; rr < 2; ++rr) { offd[rr] = clampi(ra + rr - 4, 0, G.rows - 8) - G.j0; tq[rr] = G.base + (ra + rr) * 64 + c; tb[rr] = (unsigned)((G.j0 - (ra + rr) + 8) * 128); }
        bf16x8 qf[2][4];
#pragma unroll
        for (int rr = 0; rr < 2; ++rr)
#pragma unroll
            for (int ks = 0; ks < 4; ++ks) qf[rr][ks] = qn[rr][ks];
        f32x4 O[2][8]; float sum[2] = {0.f, 0.f};
#pragma unroll
        for (int rr = 0; rr < 2; ++rr)
#pragma unroll
            for (int c2 = 0; c2 < 8; ++c2) O[rr][c2] = (f32x4){0.f, 0.f, 0.f, 0.f};
        const bool qnext = ui + 1 < UPW;
#pragma unroll 1
        for (int jj = 0; jj < G.nr; ++jj) {
            ATT_SYNC((qnext && jj >= 4 && jj <= 6) ? 8 : 0);
            ATT_ISSUE();
            if (jj == 3 && qnext) {
                const UnitGeo Gn = unit_geo(vcu, ui + 1);
#pragma unroll
                for (int rr = 0; rr < 2; ++rr) { const bf16* qptr = P + (size_t)(Gn.base + (Gn.r0 + 2 * grp + rr) * 64 + c) * PW + h * HD + 8 * g;
#pragma unroll
                    for (int ks = 0; ks < 4; ++ks) asm volatile("global_load_dwordx4 %0, %1, off" : "=&v"(qn[rr][ks]) : "v"(qptr + 32 * ks) : "memory"); } }
            const bool v0 = (jj >= offd[0]) && (jj < offd[0] + 8), v1 = (jj >= offd[1]) && (jj < offd[1] + 8);
            if (v0 || v1) {
                bf16x8 kf[2][4]; float bb[2][8];
#pragma unroll
                for (int hf = 0; hf < 2; ++hf)
#pragma unroll
                    for (int ks = 0; ks < 4; ++ks) kf[hf][ks] = *(const LAS bf16x8*)(size_t)(slotb + koff[hf] + 64u * ((unsigned)ks ^ kx[hf]));
                const unsigned tr0 = v0 ? tb[0] + (unsigned)(jj * 128) : 0u, tr1 = v1 ? tb[1] + (unsigned)(jj * 128) : 0u;
#pragma unroll
                for (int hf = 0; hf < 2; ++hf)
#pragma unroll
                    for (int rg = 0; rg < 4; ++rg) { bb[0][hf * 4 + rg] = *(const LAS float*)(size_t)(ci[hf][rg] + tr0); bb[1][hf * 4 + rg] = *(const LAS float*)(size_t)(ci[hf][rg] + tr1); }
                asm volatile("" : "+v"(kf[0][0]), "+v"(kf[0][1]), "+v"(kf[0][2]), "+v"(kf[0][3]), "+v"(kf[1][0]), "+v"(kf[1][1]), "+v"(kf[1][2]), "+v"(kf[1][3]));
                f32x4 S[2][2];
#pragma unroll
                for (int rr = 0; rr < 2; ++rr) { S[rr][0] = (f32x4){0.f, 0.f, 0.f, 0.f}; S[rr][1] = (f32x4){0.f, 0.f, 0.f, 0.f}; }
#pragma unroll
                for (int ks = 0; ks < 4; ++ks)
#pragma unroll
                    for (int hf = 0; hf < 2; ++hf)
#pragma unroll
                        for (int rr = 0; rr < 2; ++rr) S[rr][hf] = __builtin_amdgcn_mfma_f32_16x16x32_bf16(kf[hf][ks], qf[rr][ks], S[rr][hf], 0, 0, 0);
                bf16x8 vb[8];
#pragma unroll
                for (int c2 = 0; c2 < 8; ++c2) { const s16x4 a0 = vtr(slotb + voff[0] + 16u * ((unsigned)(2 * c2) ^ vfx[0])), a1 = vtr(slotb + voff[1] + 16u * ((unsigned)(2 * c2) ^ vfx[1]));
                    vb[c2] = (bf16x8){a0[0], a0[1], a0[2], a0[3], a1[0], a1[1], a1[2], a1[3]}; }
                __builtin_amdgcn_sched_barrier(0);
                asm volatile("" : "+v"(bb[0][0]), "+v"(bb[0][1]), "+v"(bb[0][2]), "+v"(bb[0][3]), "+v"(bb[0][4]), "+v"(bb[0][5]), "+v"(bb[0][6]), "+v"(bb[0][7]),
                                  "+v"(bb[1][0]), "+v"(bb[1][1]), "+v"(bb[1][2]), "+v"(bb[1][3]), "+v"(bb[1][4]), "+v"(bb[1][5]), "+v"(bb[1][6]), "+v"(bb[1][7]));
                bf16x8 pf[2];
#pragma unroll
                for (int rr = 0; rr < 2; ++rr) { float e[8];
#pragma unroll
                    for (int hf = 0; hf < 2; ++hf)
#pragma unroll
                        for (int rg = 0; rg < 4; ++rg) { e[hf * 4 + rg] = __builtin_amdgcn_exp2f(S[rr][hf][rg] + bb[rr][hf * 4 + rg]); sum[rr] += e[hf * 4 + rg]; }
                    pg8::u32x4 w; w.x = pg8::cvt_pk_bf16(e[0], e[1]); w.y = pg8::cvt_pk_bf16(e[2], e[3]); w.z = pg8::cvt_pk_bf16(e[4], e[5]); w.w = pg8::cvt_pk_bf16(e[6], e[7]);
                    pf[rr] = __builtin_bit_cast(bf16x8, w); }
                __builtin_amdgcn_sched_barrier(0);
                asm volatile("" : "+v"(vb[0]), "+v"(vb[1]), "+v"(vb[2]), "+v"(vb[3]), "+v"(vb[4]), "+v"(vb[5]), "+v"(vb[6]), "+v"(vb[7]));
#pragma unroll
                for (int c2 = 0; c2 < 8; ++c2)
#pragma unroll
                    for (int rr = 0; rr < 2; ++rr) O[rr][c2] = __builtin_amdgcn_mfma_f32_16x16x32_bf16(vb[c2], pf[rr], O[rr][c2], 0, 0, 0);
            }
        }
        asm volatile("" : "+v"(qn[0][0]), "+v"(qn[0][1]), "+v"(qn[0][2]), "+v"(qn[0][3]), "+v"(qn[1][0]), "+v"(qn[1][1]), "+v"(qn[1][2]), "+v"(qn[1][3]));
#pragma unroll
        for (int rr = 0; rr < 2; ++rr) {
        float sm = sum[rr]; sm += __shfl_xor(sm, 16); sm += __shfl_xor(sm, 32);
        const float inv = 1.0f / sm;
        float ssq = 0.f;
#pragma unroll
        for (int c2 = 0; c2 < 8; ++c2) { const f32x4 o = O[rr][c2] * inv; O[rr][c2] = o; ssq += (o[0] * o[0] + o[1] * o[1]) + (o[2] * o[2] + o[3] * o[3]); }
        ssq += __shfl_xor(ssq, 16); ssq += __shfl_xor(ssq, 32);
        const float rn = rsqrtf(ssq * (1.0f / 128.0f) + 1e-6f);
        if (!yi8) {
            bf16* ypb = (bf16*)Y + (size_t)tq[rr] * D + h * HD + 4 * g; const unsigned gb = ldsb + GAIN_OFF + (unsigned)((4 * g) * 4);
#pragma unroll
            for (int c2 = 0; c2 < 8; ++c2) { const f32x4 gv = *(const LAS f32x4*)(size_t)(gb + 64 * c2);
                v2u w; w.x = pg8::cvt_pk_bf16(O[rr][c2][0] * rn * gv[0], O[rr][c2][1] * rn * gv[1]); w.y = pg8::cvt_pk_bf16(O[rr][c2][2] * rn * gv[2], O[rr][c2][3] * rn * gv[3]);
                *(GAS v2u*)(ypb + 16 * c2) = w; }
        } else {
        float yv[8][4];
#pragma unroll
        for (int c2 = 0; c2 < 8; ++c2) { const float a = O[rr][c2][0] * rn, b = O[rr][c2][1] * rn, cc_ = O[rr][c2][2] * rn, d = O[rr][c2][3] * rn;
            const float s0 = a + b, s1 = a - b, s2 = cc_ + d, s3 = cc_ - d; yv[c2][0] = s0 + s2; yv[c2][1] = s1 + s3; yv[c2][2] = s0 - s2; yv[c2][3] = s1 - s3; }
#pragma unroll
        for (int bq = 0; bq < 4; ++bq)
#pragma unroll
            for (int rg = 0; rg < 4; ++rg) { const float x0 = yv[2 * bq][rg], x1 = yv[2 * bq + 1][rg]; yv[2 * bq][rg] = x0 + x1; yv[2 * bq + 1][rg] = x0 - x1; }
        const bool g0 = (g & 1) != 0, g1 = (g & 2) != 0;
        signed char* yp = Y + (size_t)tq[rr] * D + h * HD + 4 * g;
#pragma unroll
        for (int c2 = 0; c2 < 8; ++c2) { float vq[4];
#pragma unroll
            for (int rg = 0; rg < 4; ++rg) { float v = yv[c2][rg]; float p = __shfl_xor(v, 16); v = g0 ? p - v : v + p; p = __shfl_xor(v, 32); vq[rg] = g1 ? p - v : v + p; }
            *(GAS unsigned*)(yp + 16 * c2) = q8x4c(vq[0], vq[1], vq[2], vq[3], YQ); }
        }
        }
    }
    asm volatile("s_waitcnt vmcnt(0) lgkmcnt(0)" ::: "memory"); __builtin_amdgcn_s_barrier(); asm volatile("" ::: "memory");
#undef ATT_ISSUE
#undef ATT_SYNC
}
}

__device__ __forceinline__ void p2_conv(Frame& F, const bf16* P, signed char* Y, const float* conv_w, const float* cog, const bool yi8) {
    const int gw = F.vcu * NWAVES + F.wave, NGW = F.G * NWAVES, lane = F.lane;
    const int ch = (gw & 1) * 512 + 8 * lane;
    float w[3][8], gn[8]; const float s1 = (lane & 1) ? -1.0f : 1.0f, s2 = (lane & 2) ? -1.0f : 1.0f;
    { const f32x4 a = *(const GAS f32x4*)(cog + ch), b = *(const GAS f32x4*)(cog + ch + 4); gn[0] = a[0]; gn[1] = a[1]; gn[2] = a[2]; gn[3] = a[3]; gn[4] = b[0]; gn[5] = b[1]; gn[6] = b[2]; gn[7] = b[3]; }
#pragma unroll
    for (int j = 0; j < 3; ++j) { const f32x4 a = *(const GAS f32x4*)(conv_w + j * AW + ch), b = *(const GAS f32x4*)(conv_w + j * AW + ch + 4);
        w[j][0] = a[0]; w[j][1] = a[1]; w[j][2] = a[2]; w[j][3] = a[3]; w[j][4] = b[0]; w[j][5] = b[1]; w[j][6] = b[2]; w[j][7] = b[3]; }
#define CV_LOAD(cc, bb, it_) do { const int t0_ = ((it_) >> 1) * 4; int base_, L_; seq_of(t0_, base_, L_); const int tl_ = t0_ - base_; \
        _Pragma("unroll") for (int j = 0; j < 6; ++j) { const int tt_ = tl_ + j - 1; const bool ok_ = (tt_ >= 0) && (tt_ < L_); cc[j] = *(const GAS v4u*)(P + (size_t)(base_ + (ok_ ? tt_ : tl_)) * PW + 4 * AW + ch); } \
        _Pragma("unroll") for (int i = 0; i < 4; ++i) bb[i] = *(const GAS v4u*)(P + (size_t)(t0_ + i) * PW + 3 * AW + ch); } while (0)
    auto compute = [&](const v4u (&cc)[6], const v4u (&bb)[4], const int it) {
        const int t0 = (it >> 1) * 4;
        int base, L; seq_of(t0, base, L);
        const int tl = t0 - base;
        float cu[6][8];
#pragma unroll
        for (int j = 0; j < 6; ++j) { const int tt = tl + j - 1; const bool ok = (tt >= 0) && (tt < L);
            const v4u c = ok ? cc[j] : (v4u){0u, 0u, 0u, 0u};
            cu[j][0] = bflo(c.x); cu[j][1] = bfhi(c.x); cu[j][2] = bflo(c.y); cu[j][3] = bfhi(c.y); cu[j][4] = bflo(c.z); cu[j][5] = bfhi(c.z); cu[j][6] = bflo(c.w); cu[j][7] = bfhi(c.w); }
#pragma unroll
        for (int i = 0; i < 4; ++i) {
            const float bv[8] = {bflo(bb[i].x), bfhi(bb[i].x), bflo(bb[i].y), bfhi(bb[i].y), bflo(bb[i].z), bfhi(bb[i].z), bflo(bb[i].w), bfhi(bb[i].w)};
            float y[8]; float s = 0.f;
#pragma unroll
            for (int e = 0; e < 8; ++e) { y[e] = bv[e] * (w[0][e] * cu[i][e] + w[1][e] * cu[i + 1][e] + w[2][e] * cu[i + 2][e]); s += y[e] * y[e]; }
            s += __shfl_xor(s, 1); s += __shfl_xor(s, 2); s += __shfl_xor(s, 4); s += __shfl_xor(s, 8);
            const float rn = rsqrtf(s * (1.0f / 128.0f) + 1e-6f);
            if (!yi8) { v4u o; o.x = pk2(y[0] * rn * gn[0], y[1] * rn * gn[1]); o.y = pk2(y[2] * rn * gn[2], y[3] * rn * gn[3]); o.z = pk2(y[4] * rn * gn[4], y[5] * rn * gn[5]); o.w = pk2(y[6] * rn * gn[6], y[7] * rn * gn[7]);
                *(GAS v4u*)((bf16*)Y + (size_t)(t0 + i) * D + AW + ch) = o; continue; }
#pragma unroll
            for (int e = 0; e < 8; ++e) y[e] *= rn;
            wht_regs<8>(y);
#pragma unroll
            for (int e = 0; e < 8; ++e) { float v = y[e]; float p = dpp_xor1(v); v = fmaf(v, s1, p); p = dpp_xor2(v); y[e] = fmaf(v, s2, p); }
            *(GAS v2u*)(Y + (size_t)(t0 + i) * D + AW + ch) = (v2u){q8x4c(y[0], y[1], y[2], y[3], YQ), q8x4c(y[4], y[5], y[6], y[7], YQ)};
        }
    };
    constexpr int NI = M / 2;
    v4u ca[6], ba[4], cb[6], bq[4];
    if (gw < NI) CV_LOAD(ca, ba, gw);
    for (int it = gw; it < NI; it += 2 * NGW) {
        const int i1 = it + NGW, i2 = i1 + NGW;
        if (i1 < NI) CV_LOAD(cb, bq, i1);
        compute(ca, ba, it);
        if (i1 >= NI) break;
        if (i2 < NI) CV_LOAD(ca, ba, i2);
        compute(cb, bq, i1);
    }
#undef CV_LOAD
}

struct Args { const float* in[15]; float* out; unsigned char* ws; int ph_lo, ph_hi, li, pad; };
constexpr int PH_PER_LAYER = 8, N_PHASES = 1 + DEPTH * PH_PER_LAYER;
typedef __attribute__((address_space(4))) const unsigned long long kau64;
__device__ __forceinline__ kau64* karg() { kau64* p = (kau64*)__builtin_amdgcn_kernarg_segment_ptr(); asm volatile("" : "+s"(p)); return p; }
#define KA_IN(ka, i) ((const float*)(const GAS float*)(ka)[i])
#define KA_OUT(ka) ((float*)(GAS float*)(ka)[15])
#define KA_WS(ka) ((unsigned char*)(GAS unsigned char*)(ka)[16])
#define KA_LO(ka) ((int)(unsigned)((ka)[17] & 0xffffffffull))
#define KA_HI(ka) ((int)(unsigned)((ka)[17] >> 32))

__device__ __forceinline__ int opaque_bx() { int bx = blockIdx.x; asm volatile("" : "+s"(bx)); return bx; }
__device__ __forceinline__ Frame make_frame(LAS unsigned char* lds, const int wv) {
    Frame F; F.lds = lds; F.MISC = (volatile LAS unsigned*)(lds + MISC_OFF);
    { int t_ = tid_of(wv); asm volatile("" : "+v"(t_)); F.tid = t_; } F.lane = F.tid & 63; F.wave = __builtin_amdgcn_readfirstlane(F.tid >> 6);
    F.G = gridDim.x; { int bx = blockIdx.x; asm volatile("" : "+s"(bx)); F.vcu = (F.G % 8 == 0) ? (bx % 8) * (F.G / 8) + bx / 8 : bx; }
    F.ctl = nullptr; return F;
}
__device__ __forceinline__ LayerW make_lw(kau64* ka, int layer) {
    LayerW W;
    W.norm1 = KA_IN(ka, 2) + (size_t)layer * D; W.w_in = KA_IN(ka, 3) + (size_t)layer * D * NIN; W.qg = KA_IN(ka, 4) + layer * HD; W.kg = KA_IN(ka, 5) + layer * HD;
    W.rpb = KA_IN(ka, 6) + (size_t)layer * NH * 15 * 31; W.conv_w = KA_IN(ka, 7) + (size_t)layer * 3 * AW; W.aog = KA_IN(ka, 8) + layer * AW; W.cog = KA_IN(ka, 9) + layer * AW;
    W.w_out = KA_IN(ka, 10) + (size_t)layer * D * D; W.norm2 = KA_IN(ka, 11) + (size_t)layer * D;
    W.w_gate = KA_IN(ka, 12) + (size_t)layer * D * FF; W.w_up = KA_IN(ka, 13) + (size_t)layer * D * FF; W.w_down = KA_IN(ka, 14) + (size_t)layer * FF * D;
    return W;
}
__device__ __forceinline__ void seam(LAS unsigned char* lds, int k, const int wv) {
    kau64* ka = karg();
    if (!(KA_LO(ka) <= k + 1 && k + 1 < KA_HI(ka))) return;
    XcdBarrier b; b.bar = (unsigned*)(KA_WS(ka) + WS_CTL) + CW_BAR; b.x = xb_xcc_id(); b.st = (volatile LAS unsigned*)(lds + MISC_OFF) + 8;
    xcd_barrier(b, wv);
}
__device__ __forceinline__ bool in_range(int k) { kau64* ka = karg(); return KA_LO(ka) <= k && k < KA_HI(ka); }

__global__ void __launch_bounds__(NWAVES * 64, 2) enc_fwd(Args args) {
    extern __shared__ __attribute__((aligned(16))) unsigned char lds_raw[];
    LAS unsigned char* lds = (LAS unsigned char*)lds_raw;
    const int wv = __builtin_amdgcn_readfirstlane((int)threadIdx.x >> 6);
    for (int u = tid_of(wv); u < (LDS_BYTES - LDSCTL_OFF) / 4; u += NWAVES * 64) ((LAS unsigned*)(lds + LDSCTL_OFF))[u] = 0u;
    __syncthreads();
    { kau64* ka = karg(); (void)xcd_barrier_post((unsigned*)(KA_WS(ka) + WS_CTL) + CW_BAR, (volatile LAS unsigned*)(lds + MISC_OFF) + 8, wv); }

    if (in_range(0)) {
        kau64* ka = karg(); unsigned char* ws = KA_WS(ka); Frame F = make_frame(lds, wv);
        for (int rep = 0; rep < DUPN(32); ++rep) pa_colmax(F, KA_IN(ka, 12), KA_IN(ka, 13), KA_IN(ka, 11), (unsigned*)(ws + WS_CMAX), KA_IN(ka, 14), (unsigned*)(ws + WS_CMAXD), KA_IN(ka, 10), KA_IN(ka, 8), KA_IN(ka, 9), (unsigned*)(ws + WS_CMAXO), KA_IN(ka, 3), KA_IN(ka, 2), (unsigned*)(ws + WS_CMAXI));
        __syncthreads();
        seam(lds, 0, wv);
    }
    for (int layer = 0; layer < DEPTH; ++layer) {
        const int pb = 1 + layer * PH_PER_LAYER;
        if (in_range(pb + 0)) {
            kau64* ka = karg(); unsigned char* ws = KA_WS(ka); Frame F = make_frame(lds, wv); const LayerW W = make_lw(ka, layer);
            for (int rep = 0; rep < DUPN(1); ++rep) p0_weights(F, W, (bf16*)(ws + WS_WIN), (signed char*)(ws + WS_WOUT), (signed char*)(ws + WS_WGU), (signed char*)(ws + WS_WD), (const unsigned*)(ws + WS_CMAX) + layer * NGU, (float*)(ws + WS_SB), (const unsigned*)(ws + WS_CMAXD) + layer * D, (const unsigned*)(ws + WS_CMAXO) + layer * D, layer >= P3I8_FROM, (const unsigned*)(ws + WS_CMAXI) + layer * NIN, layer >= P1I8_FROM, layer == 0 ? 0 : 2);
            if (layer == 0) p0_x(F, KA_IN(ka, 0), KA_IN(ka, 1), KA_OUT(ka), (bf16*)(ws + WS_XB), (float*)(ws + WS_RS));
            else if (layer >= P1I8_FROM) r_quant(F, (const float*)(ws + WS_SSP), (const bf16*)(ws + WS_XB), (signed char*)(ws + WS_XQ), (float*)(ws + WS_RS), (float*)(ws + WS_RS) + 4 * M);
            else reduce_rs(F, (const float*)(ws + WS_SSP), (float*)(ws + WS_RS));
            __syncthreads();
            seam(lds, pb + 0, wv);
        }
        if (in_range(pb + 1)) {
            kau64* ka = karg(); unsigned char* ws = KA_WS(ka);
            if (layer >= P1I8_FROM && P1I8_FROM > 0) {
            pg8::Gemm g{(const bf16*)(ws + WS_XQ), (const bf16*)(ws + WS_WIN), M, NIN, D / 2}; pg8::StaticOrder S; S.init(M, NIN, (int)gridDim.x, opaque_bx());
            pg8::EpiInProj E{(bf16*)(ws + WS_P), (const float*)(ws + WS_RS) + 4 * M, KA_IN(ka, 4) + layer * HD, KA_IN(ka, 5) + layer * HD, (LAS float*)(lds + QKTAB_OFF), (const float*)(ws + WS_SB) + NGU + 2 * D};
            pg8::gemm_phase<pg8::EpiInProj, pg8::StaticOrder, PG8_ALIGN, PG8_SP2, true>(lds + RING_OFF, g, S, E, wv);
            } else {
            pg8::Gemm g{(const bf16*)(ws + WS_XB), (const bf16*)(ws + WS_WIN), M, NIN, D}; pg8::StaticOrder S; S.init(M, NIN, (int)gridDim.x, opaque_bx());
            pg8::EpiInProj E{(bf16*)(ws + WS_P), (const float*)(ws + WS_RS), KA_IN(ka, 4) + layer * HD, KA_IN(ka, 5) + layer * HD, (LAS float*)(lds + QKTAB_OFF), nullptr};
            for (int rep = 0; rep < DUPN(8); ++rep) pg8::gemm_phase<pg8::EpiInProj, pg8::StaticOrder, PG8_ALIGN, PG8_SP2>(lds + RING_OFF, g, S, E, wv);
            }
            seam(lds, pb + 1, wv);
        }
        if (in_range(pb + 2)) {
            kau64* ka = karg(); unsigned char* ws = KA_WS(ka); Frame F = make_frame(lds, wv);
            for (int rep = 0; rep < DUPN(64); ++rep) att::attention(lds, (const bf16*)(ws + WS_P), (signed char*)(ws + WS_Y), KA_IN(ka, 6) + (size_t)layer * NH * 15 * 31, KA_IN(ka, 8) + layer * AW, KA_IN(ka, 4) + layer * HD, KA_IN(ka, 5) + layer * HD, layer >= P3I8_FROM, F.vcu, wv);
            for (int rep = 0; rep < DUPN(128); ++rep) p2_conv(F, (const bf16*)(ws + WS_P), (signed char*)(ws + WS_Y), KA_IN(ka, 7) + (size_t)layer * 3 * AW, KA_IN(ka, 9) + layer * AW, layer >= P3I8_FROM);
            for (int rep = 0; rep < DUPN(2) - 1; ++rep) {
            att::attention(lds, (const bf16*)(ws + WS_P), (signed char*)(ws + WS_Y), KA_IN(ka, 6) + (size_t)layer * NH * 15 * 31, KA_IN(ka, 8) + layer * AW, KA_IN(ka, 4) + layer * HD, KA_IN(ka, 5) + layer * HD, layer >= P3I8_FROM, F.vcu, wv);
            p2_conv(F, (const bf16*)(ws + WS_P), (signed char*)(ws + WS_Y), KA_IN(ka, 7) + (size_t)layer * 3 * AW, KA_IN(ka, 9) + layer * AW, layer >= P3I8_FROM);
            __syncthreads(); }
            __syncthreads();
            seam(lds, pb + 2, wv);
        }
        if (in_range(pb + 3)) {
            kau64* ka = karg(); unsigned char* ws = KA_WS(ka);
            if (layer >= P3I8_FROM) {
            pg8::Gemm g{(const bf16*)(ws + WS_Y), (const bf16*)(ws + WS_WOUT), M, D, D / 2}; pg8::StaticOrder S; S.init(M, D, (int)gridDim.x, opaque_bx());
            pg8::EpiResidI8 E{nullptr, (bf16*)(ws + WS_XB), nullptr, nullptr, (const float*)(ws + WS_SB) + NGU + D, YS};
            pg8::gemm_phase<pg8::EpiResidI8, pg8::StaticOrder, PG8_ALIGN, PG8_SP2, true>(lds + RING_OFF, g, S, E, wv);
            } else {
            pg8::Gemm g{(const bf16*)(ws + WS_Y), (const bf16*)(ws + WS_WOUT), M, D, D}; pg8::StaticOrder S; S.init(M, D, (int)gridDim.x, opaque_bx());
            pg8::EpiResid E{nullptr, (bf16*)(ws + WS_XB), nullptr};
            pg8::gemm_phase<pg8::EpiResid, pg8::StaticOrder, PG8_ALIGN, PG8_SP2>(lds + RING_OFF, g, S, E, wv);
            }
            seam(lds, pb + 3, wv);
        }
        if (in_range(pb + 4)) {
            kau64* ka = karg(); unsigned char* ws = KA_WS(ka); Frame F = make_frame(lds, wv);
            for (int rep = 0; rep < DUPN(4); ++rep) r_quant(F, (const float*)(ws + WS_SSP), (const bf16*)(ws + WS_XB), (signed char*)(ws + WS_XQ), (float*)(ws + WS_RS) + M, (float*)(ws + WS_RS) + 2 * M);
            __syncthreads();
            seam(lds, pb + 4, wv);
        }
        if (in_range(pb + 5)) {
            kau64* ka = karg(); unsigned char* ws = KA_WS(ka);
            pg8::Gemm g{(const bf16*)(ws + WS_XQ), (const bf16*)(ws + WS_WGU), M, NGU, D / 2};
            pg8::StealOrder S; S.init(M, NGU, (int)gridDim.x, opaque_bx(), P4_STATIC_STEPS, (unsigned long long*)((unsigned*)(ws + WS_CTL) + CW_STEAL + 512 * layer), (volatile LAS int*)(lds + LDSCTL_OFF + 512));
            pg8::EpiGateUpI8 E{(bf16*)(ws + WS_H), (const float*)(ws + WS_RS) + 2 * M, (const float*)(ws + WS_SB)};
            pg8::gemm_phase<pg8::EpiGateUpI8, pg8::StealOrder, PG8_ALIGN, PG8_SP2, true>(lds + RING_OFF, g, S, E, wv);
            seam(lds, pb + 5, wv);
        }
        if (in_range(pb + 6)) {
            kau64* ka = karg(); unsigned char* ws = KA_WS(ka); Frame F = make_frame(lds, wv);
            h_quant(F, (const bf16*)(ws + WS_H), (signed char*)(ws + WS_H8), (float*)(ws + WS_RS) + 3 * M);
            __syncthreads();
            seam(lds, pb + 6, wv);
        }
        if (in_range(pb + 7)) {
            kau64* ka = karg(); unsigned char* ws = KA_WS(ka); const bool lastl = (layer == DEPTH - 1);
            pg8::Gemm g{(const bf16*)(ws + WS_H8), (const bf16*)(ws + WS_WD), M, D, FF / 2}; pg8::StaticOrder S; S.init(M, D, (int)gridDim.x, opaque_bx());
            pg8::EpiResidI8 E{lastl ? KA_OUT(ka) : nullptr, (bf16*)(ws + WS_XB), (layer + 1 < P1I8_FROM) ? (float*)(ws + WS_SSP) : nullptr, (const float*)(ws + WS_RS) + 3 * M, (const float*)(ws + WS_SB) + NGU, 0.f};
            pg8::gemm_phase<pg8::EpiResidI8, pg8::StaticOrder, PG8_ALIGN, PG8_SP2, true>(lds + RING_OFF, g, S, E, wv);
            if (!lastl) { Frame F = make_frame(lds, wv); const LayerW Wn = make_lw(ka, layer + 1);
                p0_weights(F, Wn, (bf16*)(ws + WS_WIN), (signed char*)(ws + WS_WOUT), (signed char*)(ws + WS_WGU), (signed char*)(ws + WS_WD), (const unsigned*)(ws + WS_CMAX) + (layer + 1) * NGU, (float*)(ws + WS_SB), (const unsigned*)(ws + WS_CMAXD) + (layer + 1) * D, (const unsigned*)(ws + WS_CMAXO) + (layer + 1) * D, layer + 1 >= P3I8_FROM, (const unsigned*)(ws + WS_CMAXI) + (layer + 1) * NIN, layer + 1 >= P1I8_FROM, 1);
                __syncthreads();
                seam(lds, pb + 7, wv); }
        }
    }
    { kau64* ka = karg();
      if (KA_HI(ka) == N_PHASES && xb_ld((unsigned*)(KA_WS(ka) + WS_CTL) + CW_BAR + XB_TMO) != 0u) {
          float* X = KA_OUT(ka); const float q = __builtin_nanf("");
          for (size_t i = (size_t)blockIdx.x * 512 + tid_of(wv); i < (size_t)M * D / 64; i += (size_t)gridDim.x * 512) X[i * 64] = q; } }
}

extern "C" void kernel_launch(void* const* d_in, const int* in_sizes, int n_in, void* d_out, int out_size, void* d_ws, size_t ws_size, hipStream_t stream) {
    static int grid = 0;
    if (grid == 0) {
        if (n_in != 15 || out_size != M * D || ws_size < WS_END) { fprintf(stderr, "kernel_launch: unexpected shapes (n_in %d, out %d, ws %zu)\n", n_in, out_size, ws_size); grid = -1; return; }
        int dev = 0, cus = 0, per_cu = 0;
        if (hipGetDevice(&dev) != hipSuccess || hipDeviceGetAttribute(&cus, hipDeviceAttributeMultiprocessorCount, dev) != hipSuccess) { grid = -1; return; }
        if (hipFuncSetAttribute((const void*)enc_fwd, hipFuncAttributeMaxDynamicSharedMemorySize, LDS_BYTES) != hipSuccess) { fprintf(stderr, "kernel_launch: hipFuncSetAttribute failed\n"); grid = -1; return; }
        if (hipOccupancyMaxActiveBlocksPerMultiprocessor(&per_cu, (const void*)enc_fwd, NWAVES * 64, LDS_BYTES) != hipSuccess || per_cu < 1) { fprintf(stderr, "kernel_launch: occupancy query says %d\n", per_cu); }
        (void)hipGetLastError();
        grid = cus;
    }
    if (grid < 0) return;
    if (hipMemsetAsync((char*)d_ws, 0, ZERO_BYTES, stream) != hipSuccess) { fprintf(stderr, "kernel_launch: memset failed\n"); return; }
    Args a{};
    for (int i = 0; i < 15; ++i) a.in[i] = (const float*)d_in[i];
    a.out = (float*)d_out; a.ws = (unsigned char*)d_ws;
    constexpr int NL = MK_N_LAUNCHES;
    for (int li = 0; li < NL; ++li) {
        a.ph_lo = (NL == 1) ? 0 : li; a.ph_hi = (NL == 1) ? N_PHASES : li + 1; a.li = (NL == 1) ? 0 : 0; a.pad = 0;
        hipLaunchKernelGGL(enc_fwd, dim3(grid), dim3(NWAVES * 64), LDS_BYTES, stream, a);
        const hipError_t le = hipPeekAtLastError();
        if (le != hipSuccess) { fprintf(stderr, "kernel_launch: launch failed: %s\n", hipGetErrorName(le)); break; }
    }
}
```
